# Optimizing an MI355X kernel written in HIP

```python
import jax, jax.numpy as jnp
from jax import lax
import numpy as np

D_MODEL = 1024
BATCH = 8
SEQ = 4096
DEPTH = 1

N_MLA_HEADS = 8
MLA_Q_RANK = 256
MLA_KV_RANK = 128
MLA_NOPE_DIM = 64
MLA_ROPE_DIM = 32
MLA_V_DIM = 64
ROPE_THETA = 10000.0
Q_BLOCK = 128

N_GDN_HEADS = 8
GDN_HEAD_DIM = 64
GDN_CONV = 4
GDN_CHUNK = 64

MLA_W = N_MLA_HEADS * MLA_V_DIM
GDN_W = N_GDN_HEADS * GDN_HEAD_DIM
D_MIX = MLA_W + GDN_W
D_IN = MLA_Q_RANK + MLA_KV_RANK + MLA_ROPE_DIM + 3 * GDN_W + 2 * N_GDN_HEADS + GDN_W

D_FF = 2816
EPS = 1e-6

kernel_name = "hybrid_mla_gdn_macaron_sandwich"


def rmsnorm(x, g):
    xf = x.astype(jnp.float32)
    y = xf * lax.rsqrt(jnp.mean(xf * xf, axis=-1, keepdims=True) + EPS)
    return (y * g.astype(jnp.float32)).astype(x.dtype)


def l2norm(x):
    xf = x.astype(jnp.float32)
    return xf * lax.rsqrt(jnp.sum(xf * xf, axis=-1, keepdims=True) + EPS)


def swiglu(x, w_gate, w_up, w_down):
    return (jax.nn.silu(x @ w_gate) * (x @ w_up)) @ w_down


def rope_tables(positions):
    half = MLA_ROPE_DIM // 2
    freqs = ROPE_THETA ** (-jnp.arange(half, dtype=jnp.float32) / half)
    ang = positions.astype(jnp.float32)[..., None] * freqs
    return jnp.cos(ang), jnp.sin(ang)


def apply_rope(x, cos, sin):
    x1, x2 = jnp.split(x.astype(jnp.float32), 2, axis=-1)
    return jnp.concatenate([x1 * cos - x2 * sin, x1 * sin + x2 * cos], axis=-1).astype(x.dtype)


def mla_group(c_q, c_kv, k_rope_raw, positions, q_norm_g, w_uq, kv_norm_g, w_ukv):
    B, T, _ = c_q.shape
    H = N_MLA_HEADS
    q = (rmsnorm(c_q, q_norm_g) @ w_uq).reshape(B, T, H, MLA_NOPE_DIM + MLA_ROPE_DIM)
    q_nope, q_pe = q[..., :MLA_NOPE_DIM], q[..., MLA_NOPE_DIM:]
    kv = (rmsnorm(c_kv, kv_norm_g) @ w_ukv).reshape(B, T, H, MLA_NOPE_DIM + MLA_V_DIM)
    k_nope, v = kv[..., :MLA_NOPE_DIM], kv[..., MLA_NOPE_DIM:]
    cos, sin = rope_tables(positions)
    q_pe = apply_rope(q_pe, cos[:, :, None], sin[:, :, None])
    k_pe = apply_rope(k_rope_raw, cos, sin)
    scale = (MLA_NOPE_DIM + MLA_ROPE_DIM) ** -0.5
    nb = T // Q_BLOCK
    qn_b = q_nope.reshape(B, nb, Q_BLOCK, H, MLA_NOPE_DIM).transpose(1, 0, 2, 3, 4)
    qp_b = q_pe.reshape(B, nb, Q_BLOCK, H, MLA_ROPE_DIM).transpose(1, 0, 2, 3, 4)
    key_pos = jnp.arange(T)

    def attend(args):
        qn, qp, blk = args
        s = (jnp.einsum('bqhd,bkhd->bhqk', qn, k_nope)
             + jnp.einsum('bqhr,bkr->bhqk', qp, k_pe)).astype(jnp.float32) * scale
        q_pos = blk * Q_BLOCK + jnp.arange(Q_BLOCK)
        causal = key_pos[None, :] <= q_pos[:, None]
        s = jnp.where(causal, s, -jnp.inf)
        p = jax.nn.softmax(s, axis=-1).astype(v.dtype)
        return jnp.einsum('bhqk,bkhd->bqhd', p, v)

    o = lax.map(attend, (qn_b, qp_b, jnp.arange(nb)))
    return o.transpose(1, 0, 2, 3, 4).reshape(B, T, H * MLA_V_DIM)


def causal_conv(x, w):
    K, C = w.shape
    return lax.conv_general_dilated(
        x, w[:, None, :], window_strides=(1,), padding=[(K - 1, 0)],
        dimension_numbers=('NWC', 'WIO', 'NWC'), feature_group_count=C)


def gated_delta_rule(q, k, v, g, beta):
    out_dtype = v.dtype
    B, T, H, dk = q.shape
    dv = v.shape[-1]
    C = GDN_CHUNK
    N = T // C
    f32 = jnp.float32
    q = q.astype(f32) * dk ** -0.5
    k, v, g, beta = k.astype(f32), v.astype(f32), g.astype(f32), beta.astype(f32)

    def to_chunks(t):
        return t.reshape((B, N, C, H) + t.shape[3:]).swapaxes(2, 3)

    qc, kc, vc, gc, bc = map(to_chunks, (q, k, v, g, beta))
    gc = jnp.cumsum(gc, axis=-1)
    tril = jnp.tril(jnp.ones((C, C), dtype=bool))
    strict = jnp.tril(jnp.ones((C, C), dtype=bool), -1)
    diff = gc[..., :, None] - gc[..., None, :]
    decay = jnp.exp(jnp.where(tril, diff, -jnp.inf))
    kb = kc * bc[..., None]
    L = jnp.where(strict, jnp.einsum('bnhid,bnhjd->bnhij', kb, kc) * decay, 0.0)
    A = jnp.eye(C, dtype=f32) + L
    w = lax.linalg.triangular_solve(A, kb * jnp.exp(gc)[..., None],
                                    left_side=True, lower=True, unit_diagonal=True)
    u = lax.linalg.triangular_solve(A, vc * bc[..., None],
                                    left_side=True, lower=True, unit_diagonal=True)
    attn = jnp.einsum('bnhid,bnhjd->bnhij', qc, kc) * decay
    q_dec = qc * jnp.exp(gc)[..., None]
    k_dec = kc * jnp.exp(gc[..., -1:] - gc)[..., None]
    g_last = jnp.exp(gc[..., -1])

    def step(S, xs):
        q_d, w_i, u_i, attn_i, k_d, gl = xs
        v_new = u_i - jnp.einsum('bhcd,bhde->bhce', w_i, S)
        o = jnp.einsum('bhcd,bhde->bhce', q_d, S) + jnp.einsum('bhij,bhje->bhie', attn_i, v_new)
        S = S * gl[..., None, None] + jnp.einsum('bhcd,bhce->bhde', k_d, v_new)
        return S, o

    xs = tuple(jnp.moveaxis(t, 1, 0) for t in (q_dec, w, u, attn, k_dec, g_last))
    S0 = jnp.zeros((B, H, dk, dv), f32)
    _, o = lax.scan(step, S0, xs)
    return o.transpose(1, 0, 3, 2, 4).reshape(B, T, H, dv).astype(out_dtype)


def setup_inputs(seed: int = 0) -> dict:
    key = jax.random.key(seed)
    ks = jax.random.split(key, 32)
    f32 = jnp.float32

    def nrm(k, shape, fan_in):
        return jax.random.normal(k, shape, f32) * fan_in ** -0.5

    def gain(k, shape):
        return 1.0 + 0.02 * jax.random.normal(k, shape, f32)

    L = DEPTH
    x = jax.random.normal(ks[0], (BATCH, SEQ, D_MODEL), f32)
    offset = jax.random.randint(ks[1], (BATCH, 1), 0, 2048, dtype=jnp.int32)
    positions = offset + jnp.arange(SEQ, dtype=jnp.int32)[None, :]
    a_log = jnp.log(jax.random.uniform(ks[17], (L, N_GDN_HEADS), f32, 1.0, 16.0))
    dt = jnp.exp(jax.random.uniform(ks[18], (L, N_GDN_HEADS), f32, np.log(1e-3), np.log(1e-1)))
    dt_bias = dt + jnp.log(-jnp.expm1(-dt))
    return {
        "x": x,
        "positions": positions,
        "ffn1_pre_g": gain(ks[2], (L, D_MODEL)),
        "ffn1_w_gate": nrm(ks[3], (L, D_MODEL, D_FF), D_MODEL),
        "ffn1_w_up": nrm(ks[4], (L, D_MODEL, D_FF), D_MODEL),
        "ffn1_w_down": nrm(ks[5], (L, D_FF, D_MODEL), D_FF),
        "ffn1_post_g": gain(ks[6], (L, D_MODEL)),
        "mix_pre_g": gain(ks[7], (L, D_MODEL)),
        "w_in": nrm(ks[8], (L, D_MODEL, D_IN), D_MODEL),
        "mla_q_norm_g": gain(ks[9], (L, MLA_Q_RANK)),
        "mla_w_uq": nrm(ks[10], (L, MLA_Q_RANK, N_MLA_HEADS * (MLA_NOPE_DIM + MLA_ROPE_DIM)), MLA_Q_RANK),
        "mla_kv_norm_g": gain(ks[11], (L, MLA_KV_RANK)),
        "mla_w_ukv": nrm(ks[12], (L, MLA_KV_RANK, N_MLA_HEADS * (MLA_NOPE_DIM + MLA_V_DIM)), MLA_KV_RANK),
        "mla_out_g": gain(ks[13], (L, MLA_W)),
        "gdn_conv_w": nrm(ks[14], (L, GDN_CONV, 3 * GDN_W), GDN_CONV),
        "gdn_a_log": a_log,
        "gdn_dt_bias": dt_bias,
        "gdn_norm_g": gain(ks[15], (L, GDN_HEAD_DIM)),
        "w_out": nrm(ks[16], (L, D_MIX, D_MODEL), D_MIX),
        "mix_post_g": gain(ks[19], (L, D_MODEL)),
        "ffn2_pre_g": gain(ks[20], (L, D_MODEL)),
        "ffn2_w_gate": nrm(ks[21], (L, D_MODEL, D_FF), D_MODEL),
        "ffn2_w_up": nrm(ks[22], (L, D_MODEL, D_FF), D_MODEL),
        "ffn2_w_down": nrm(ks[23], (L, D_FF, D_MODEL), D_FF),
        "ffn2_post_g": gain(ks[24], (L, D_MODEL)),
    }


def reference(x, positions, ffn1_pre_g, ffn1_w_gate, ffn1_w_up, ffn1_w_down, ffn1_post_g,
              mix_pre_g, w_in, mla_q_norm_g, mla_w_uq, mla_kv_norm_g, mla_w_ukv, mla_out_g,
              gdn_conv_w, gdn_a_log, gdn_dt_bias, gdn_norm_g, w_out, mix_post_g,
              ffn2_pre_g, ffn2_w_gate, ffn2_w_up, ffn2_w_down, ffn2_post_g):
    B, T, _ = x.shape
    H, dh = N_GDN_HEADS, GDN_HEAD_DIM
    sizes = (MLA_Q_RANK, MLA_KV_RANK, MLA_ROPE_DIM, 3 * GDN_W, N_GDN_HEADS, N_GDN_HEADS, GDN_W)
    cuts = []
    acc = 0
    for s in sizes[:-1]:
        acc += s
        cuts.append(acc)

    for l in range(DEPTH):
        h = swiglu(rmsnorm(x, ffn1_pre_g[l]), ffn1_w_gate[l], ffn1_w_up[l], ffn1_w_down[l])
        x = x + 0.5 * rmsnorm(h, ffn1_post_g[l])

        hn = rmsnorm(x, mix_pre_g[l])
        proj = hn @ w_in[l]
        c_q, c_kv, k_pe_raw, qkv, a, b, gate = jnp.split(proj, cuts, axis=-1)

        mla_o = mla_group(c_q, c_kv, k_pe_raw, positions,
                          mla_q_norm_g[l], mla_w_uq[l], mla_kv_norm_g[l], mla_w_ukv[l])
        mla_o = rmsnorm(mla_o, mla_out_g[l])

        qkv = jax.nn.silu(causal_conv(qkv, gdn_conv_w[l]))
        q, k, v = jnp.split(qkv, 3, axis=-1)
        q = l2norm(q.reshape(B, T, H, dh))
        k = l2norm(k.reshape(B, T, H, dh))
        v = v.reshape(B, T, H, dh)
        g = -jnp.exp(gdn_a_log[l].astype(jnp.float32)) * jax.nn.softplus(
            a.astype(jnp.float32) + gdn_dt_bias[l].astype(jnp.float32))
        beta = jax.nn.sigmoid(b.astype(jnp.float32))
        o = gated_delta_rule(q, k, v, g, beta)
        o = rmsnorm(o, gdn_norm_g[l]) * jax.nn.silu(gate.reshape(B, T, H, dh))
        gdn_o = o.reshape(B, T, GDN_W)

        mixed = jnp.concatenate([mla_o, gdn_o], axis=-1) @ w_out[l]
        x = x + rmsnorm(mixed, mix_post_g[l])

        h = swiglu(rmsnorm(x, ffn2_pre_g[l]), ffn2_w_gate[l], ffn2_w_up[l], ffn2_w_down[l])
        x = x + 0.5 * rmsnorm(h, ffn2_post_g[l])
    return x
```

```cpp
#include <hip/hip_runtime.h>
#include <hip/hip_cooperative_groups.h>
#include <cstdio>
#include <cstdint>
#include <cmath>
namespace cg = cooperative_groups;
namespace pg8 {
#define PG8_LAS __attribute__((address_space(3)))
typedef unsigned short bf16_t;
typedef short bf16x8 __attribute__((ext_vector_type(8)));
typedef float f32x4 __attribute__((ext_vector_type(4)));
typedef unsigned u32x4 __attribute__((ext_vector_type(4)));
constexpr int BM = 256, BK = 64, HALF = 128, HTB = HALF * BK * 2  , STAGE_BYTES = 8 * HTB, NXCD = 8, WGM = 8;

__host__ __device__ __forceinline__ int lds_byte(int r, int c) { const int st = (r >> 4) * 2 + (c >> 5), rr = r & 15, cc = c & 31, ob = rr * 64 + cc * 2; return st * 1024 + (ob ^ (((ob >> 9) & 1) << 5)); }
__host__ __device__ __forceinline__ void stage_rc(int b, int& R, int& C) { const int st = b / 1024, sb = b % 1024, swz = sb ^ (((sb >> 9) & 1) << 5); R = (st >> 1) * 16 + swz / 64; C = (st & 1) * 32 + (swz % 64) / 2; }
__host__ __device__ __forceinline__ int perm32(int rho) { const int n = rho >> 4, i = rho & 15; return 8 * (i >> 2) + 4 * n + (i & 3); }

struct Unit { int pm, pn; };
struct Gemm { const bf16_t* A; const bf16_t* Bt; int M, N, K; };

struct StaticOrder {
    int nM, nN, nwg, G, c;
    __host__ __device__ void init(int M, int N, int G_, int c_) { nM = M / BM; nN = N / BM; nwg = nM * nN; G = G_; c = c_; }
    __host__ __device__ bool next(int i, Unit& u) const {
        const long L = (long)i * G + c; if (L >= nwg) return false;
        int wgid = (int)L; { const int q = nwg / NXCD, r = nwg % NXCD, xcd = wgid % NXCD, off = wgid / NXCD; wgid = (xcd < r ? xcd * (q + 1) : r * (q + 1) + (xcd - r) * q) + off; }
        const int nig = WGM * nN, gid = wgid / nig, fm = gid * WGM, gsz = (nM - fm) < WGM ? (nM - fm) : WGM;
        u.pm = fm + ((wgid % nig) % gsz); u.pn = (wgid % nig) / gsz; return true;
    }
    __device__ __forceinline__ void a_ready(const Unit&) const {}
    __device__ __forceinline__ void done(const Unit&) const {}
};

__device__ __forceinline__ unsigned cvt_pk_bf16(float lo, float hi) { unsigned r; asm volatile("v_cvt_pk_bf16_f32 %0, %1, %2" : "=v"(r) : "v"(lo), "v"(hi)); return r; }
struct EpiSwiGLU {
    static constexpr bool PERM = true, AFTER_DRAIN = false;
    bf16_t* O; int ldc; const float* rs;
    __device__ __forceinline__ void operator()(const f32x4 (&acc)[2][2][4][2], const Unit& u, int wr, int wc, int fr, int fq) const {
        const int row0 = u.pm * BM + wr * 64 + fr, col0 = u.pn * 128 + wc * 32 + 8 * fq;
#pragma unroll
        for (int ai = 0; ai < 2; ++ai)
#pragma unroll
            for (int m = 0; m < 4; ++m) {
                bf16_t* p = O + (size_t)(row0 + ai * HALF + m * 16) * ldc + col0;
                float h[8]; const float rsc = rs ? rs[row0 + ai * HALF + m * 16] : 1.0f;
#pragma unroll
                for (int n = 0; n < 2; ++n)
#pragma unroll
                    for (int i = 0; i < 4; ++i) { const float g = acc[ai][0][m][n][i] * rsc, uu = acc[ai][1][m][n][i] * rsc; h[4 * n + i] = g * __builtin_amdgcn_rcpf(1.0f + __builtin_amdgcn_exp2f(g)) * uu; }
                u32x4 w; w.x = cvt_pk_bf16(h[0], h[1]); w.y = cvt_pk_bf16(h[2], h[3]); w.z = cvt_pk_bf16(h[4], h[5]); w.w = cvt_pk_bf16(h[6], h[7]);
                *(u32x4*)p = w;
            }
    }
};
struct EpiBf16Sq {
    static constexpr bool PERM = true, AFTER_DRAIN = false;
    bf16_t* O; float* rsq;
    __device__ __forceinline__ void operator()(const f32x4 (&acc)[2][2][4][2], const Unit& u, int wr, int wc, int fr, int fq) const {
        const int row0 = u.pm * BM + wr * 64 + fr, col0 = u.pn * BM + wc * 32 + 8 * fq;
#pragma unroll
        for (int ai = 0; ai < 2; ++ai)
#pragma unroll
            for (int m = 0; m < 4; ++m) {
                const int row = row0 + ai * HALF + m * 16; float s = 0.f;
#pragma unroll
                for (int bj = 0; bj < 2; ++bj) {
                    const f32x4 v0 = acc[ai][bj][m][0], v1 = acc[ai][bj][m][1];
                    s += (v0[0] * v0[0] + v0[1] * v0[1]) + (v0[2] * v0[2] + v0[3] * v0[3]) + (v1[0] * v1[0] + v1[1] * v1[1]) + (v1[2] * v1[2] + v1[3] * v1[3]);
                    u32x4 w; w.x = cvt_pk_bf16(v0[0], v0[1]); w.y = cvt_pk_bf16(v0[2], v0[3]); w.z = cvt_pk_bf16(v1[0], v1[1]); w.w = cvt_pk_bf16(v1[2], v1[3]);
                    *(u32x4*)(O + (size_t)row * 1024 + col0 + bj * HALF) = w;
                }
                s += __shfl_xor(s, 16); s += __shfl_xor(s, 32);
                if (fq == 0) rsq[(size_t)row * 16 + u.pn * 4 + wc] = s;
            }
    }
};
template <int MODE> struct EpiStore {
    static constexpr bool PERM = true, AFTER_DRAIN = false;
    bf16_t* O; int ldc; bf16_t* O2; const float* rs;
    __device__ __forceinline__ void operator()(const f32x4 (&acc)[2][2][4][2], const Unit& u, int wr, int wc, int fr, int fq) const {
        const int row0 = u.pm * BM + wr * 64 + fr;
#pragma unroll
        for (int bj = 0; bj < 2; ++bj) {
            const int c = u.pn * BM + bj * HALF + wc * 32 + 8 * fq;
            bf16_t* base; size_t ld;
            if (MODE == 1) { if (c < 1024) { base = O + c; ld = 1024; } else { base = O2 + (c - 1024); ld = 1536; } }
            else if (MODE == 2) { base = O + (c >> 6) * 96 + (c & 63); ld = (size_t)ldc; }
            else { base = O + c; ld = (size_t)ldc; }
#pragma unroll
            for (int ai = 0; ai < 2; ++ai)
#pragma unroll
                for (int m = 0; m < 4; ++m) {
                    const float rsc = rs ? rs[row0 + ai * HALF + m * 16] : 1.0f;
                    const f32x4 v0 = acc[ai][bj][m][0] * rsc, v1 = acc[ai][bj][m][1] * rsc;
                    u32x4 w; w.x = cvt_pk_bf16(v0[0], v0[1]); w.y = cvt_pk_bf16(v0[2], v0[3]); w.z = cvt_pk_bf16(v1[0], v1[1]); w.w = cvt_pk_bf16(v1[2], v1[3]);
                    *(u32x4*)(base + (size_t)(row0 + ai * HALF + m * 16) * ld) = w;
                }
        }
    }
};
template <class Epi, class Sched, bool ALIGN_EPI = false, bool SP2 = false>
__device__ __forceinline__ void gemm_phase(PG8_LAS unsigned char* lds, const Gemm g, const Sched& S, const Epi& E) {
    const int tid = threadIdx.x, wid = __builtin_amdgcn_readfirstlane(tid >> 6), lane = tid & 63, wr = wid >> 2, wc = wid & 3, fr = lane & 15, fq = lane >> 4;
    const int K = g.K, nt = K / BK;
    unsigned voffA[2], voffB[2];
#pragma unroll
    for (int i = 0; i < 2; ++i) { int R, C; stage_rc(tid * 16 + i * 8192, R, C); const int Rb = Epi::PERM ? ((R & ~31) + perm32(R & 31)) : R;
        voffA[i] = (unsigned)(R * K + C) * 2u; voffB[i] = (unsigned)(Rb * K + C) * 2u; }
    const size_t kstep = (size_t)(BK * 2);
    const size_t hstep = (size_t)HALF * K * 2;
    const size_t tstep = 2 * hstep;
    const unsigned ldsw = (unsigned)wid * 1024u;
    const int aoff = lds_byte(wr * 64 + fr, fq * 8), boff = lds_byte(wc * 32 + fr, fq * 8);
#define PG8_SA(b, h) (((b) * 2 + (h)) * HTB)
#define PG8_SB(b, h) ((4 + (b) * 2 + (h)) * HTB)
#define PG8_STAGE(bufoff, gbase, voff) do { _Pragma("unroll") for (int _i = 0; _i < 2; ++_i) \
        __builtin_amdgcn_global_load_lds((const unsigned*)((const char*)(gbase) + (voff)[_i]), (PG8_LAS unsigned*)(lds + (bufoff) + ldsw + _i * 8192), 16, 0, 0); } while (0)
#define PG8_LDA(dst, b, h) do { _Pragma("unroll") for (int m = 0; m < 4; ++m) _Pragma("unroll") for (int k = 0; k < 2; ++k) dst[m][k] = *(const PG8_LAS bf16x8*)(lds + PG8_SA(b, h) + aoff + m * 2048 + k * 1024); } while (0)
#define PG8_LDB(dst, b, h) do { _Pragma("unroll") for (int n = 0; n < 2; ++n) _Pragma("unroll") for (int k = 0; k < 2; ++k) dst[n][k] = *(const PG8_LAS bf16x8*)(lds + PG8_SB(b, h) + boff + n * 2048 + k * 1024); } while (0)
#define PG8_MMA(ai, bj, At, Bt) do { __builtin_amdgcn_s_setprio(1); _Pragma("unroll") for (int m = 0; m < 4; ++m) _Pragma("unroll") for (int n = 0; n < 2; ++n) _Pragma("unroll") for (int k = 0; k < 2; ++k) \
        acc[ai][bj][m][n] = __builtin_amdgcn_mfma_f32_16x16x32_bf16(Bt[n][k], At[m][k], acc[ai][bj][m][n], 0, 0, 0); __builtin_amdgcn_s_setprio(0); } while (0)
#define PG8_WAIT_V(n) asm volatile("s_waitcnt vmcnt(" #n ")" ::: "memory")
#define PG8_WAIT_L(n) asm volatile("s_waitcnt lgkmcnt(" #n ")" ::: "memory")
#define PG8_BAR __builtin_amdgcn_s_barrier()
#define PG8_SCHED __builtin_amdgcn_sched_barrier(0)
    Unit cur, nxt; int ui = 0;
    if (!S.next(0, cur)) return;
    f32x4 acc[2][2][4][2];
#pragma unroll
    for (int a = 0; a < 2; ++a)
#pragma unroll
        for (int b = 0; b < 2; ++b)
#pragma unroll
            for (int m = 0; m < 4; ++m)
#pragma unroll
                for (int n = 0; n < 2; ++n) acc[a][b][m][n] = (f32x4){0.f, 0.f, 0.f, 0.f};
    bf16x8 At[4][2], B0[2][2], B1[2][2];
    const char* cA = (const char*)g.A + (size_t)cur.pm * tstep; const char* cB = (const char*)g.Bt + (size_t)cur.pn * tstep;
    S.a_ready(cur);
    if constexpr (SP2) {
        PG8_STAGE(PG8_SB(0, 0), cB, voffB); PG8_STAGE(PG8_SB(0, 1), cB + hstep, voffB); PG8_STAGE(PG8_SA(0, 0), cA, voffA); PG8_STAGE(PG8_SA(0, 1), cA + hstep, voffA);
        if (wr == 1) PG8_BAR;
        PG8_WAIT_V(2); PG8_BAR;
        PG8_STAGE(PG8_SB(1, 0), cB + kstep, voffB); PG8_STAGE(PG8_SA(1, 0), cA + kstep, voffA); PG8_STAGE(PG8_SB(1, 1), cB + hstep + kstep, voffB);
        PG8_WAIT_V(6); PG8_BAR;
    } else {
        PG8_STAGE(PG8_SB(0, 0), cB, voffB); PG8_STAGE(PG8_SA(0, 0), cA, voffA); PG8_STAGE(PG8_SB(0, 1), cB + hstep, voffB); PG8_STAGE(PG8_SA(0, 1), cA + hstep, voffA);
        if (wr == 1) PG8_BAR;
        PG8_WAIT_V(4); PG8_BAR;
        PG8_STAGE(PG8_SB(1, 0), cB + kstep, voffB); PG8_STAGE(PG8_SA(1, 0), cA + kstep, voffA); PG8_STAGE(PG8_SB(1, 1), cB + hstep + kstep, voffB);
        PG8_WAIT_V(6); PG8_BAR;
    }
    for (;;) {
        const bool has_next = S.next(ui + 1, nxt);
        const char* nA = has_next ? (const char*)g.A + (size_t)nxt.pm * tstep : cA; const char* nB = has_next ? (const char*)g.Bt + (size_t)nxt.pn * tstep : cB;
        for (int t = 0; t < nt; t += 2) {
            const bool last = (t == nt - 2);
            const char* a1 = cA + (size_t)(t + 1) * kstep;
            const char* a2 = last ? nA : cA + (size_t)(t + 2) * kstep; const char* b2 = last ? nB : cB + (size_t)(t + 2) * kstep;
            const char* a3 = a2 + kstep; const char* b3 = b2 + kstep;
            if (last && has_next) S.a_ready(nxt);
            if constexpr (SP2) {
            PG8_LDB(B0, 0, 0); PG8_LDB(B1, 0, 1); PG8_SCHED; PG8_LDA(At, 0, 0); PG8_STAGE(PG8_SA(1, 1), a1 + hstep, voffA);
            PG8_WAIT_V(8); PG8_WAIT_L(0); PG8_BAR; PG8_MMA(0, 0, At, B0); PG8_MMA(0, 1, At, B1); PG8_BAR; PG8_SCHED;
            PG8_LDA(At, 0, 1); PG8_STAGE(PG8_SB(0, 0), b2, voffB); PG8_STAGE(PG8_SB(0, 1), b2 + hstep, voffB); PG8_STAGE(PG8_SA(0, 0), a2, voffA);
            PG8_WAIT_V(8); PG8_WAIT_L(0); PG8_BAR; PG8_MMA(1, 0, At, B0); PG8_MMA(1, 1, At, B1); PG8_BAR; PG8_SCHED;
            PG8_LDB(B0, 1, 0); PG8_LDB(B1, 1, 1); PG8_SCHED; PG8_LDA(At, 1, 0); PG8_STAGE(PG8_SA(0, 1), a2 + hstep, voffA);
            PG8_WAIT_V(8); PG8_WAIT_L(0); PG8_BAR; PG8_MMA(0, 0, At, B0); PG8_MMA(0, 1, At, B1); PG8_BAR; PG8_SCHED;
            PG8_LDA(At, 1, 1); PG8_STAGE(PG8_SB(1, 0), b3, voffB); PG8_STAGE(PG8_SB(1, 1), b3 + hstep, voffB); PG8_STAGE(PG8_SA(1, 0), a3, voffA);
            PG8_WAIT_V(8); PG8_WAIT_L(0); PG8_BAR; PG8_MMA(1, 0, At, B0); PG8_MMA(1, 1, At, B1); PG8_BAR; PG8_SCHED;
            } else {
            PG8_LDB(B0, 0, 0); PG8_SCHED; PG8_LDA(At, 0, 0); PG8_STAGE(PG8_SA(1, 1), a1 + hstep, voffA);
            PG8_WAIT_L(8); PG8_BAR; PG8_WAIT_L(0); PG8_MMA(0, 0, At, B0); PG8_BAR; PG8_SCHED;
            PG8_LDB(B1, 0, 1); PG8_STAGE(PG8_SB(0, 0), b2, voffB);
            PG8_BAR; PG8_WAIT_L(0); PG8_MMA(0, 1, At, B1); PG8_BAR;
            PG8_LDA(At, 0, 1); PG8_STAGE(PG8_SA(0, 0), a2, voffA);
            PG8_BAR; PG8_WAIT_L(0); PG8_MMA(1, 0, At, B0); PG8_BAR; PG8_SCHED;
            PG8_STAGE(PG8_SB(0, 1), b2 + hstep, voffB);
            PG8_WAIT_V(6); PG8_BAR; PG8_MMA(1, 1, At, B1); PG8_BAR;
            PG8_LDB(B0, 1, 0); PG8_SCHED; PG8_LDA(At, 1, 0); PG8_STAGE(PG8_SA(0, 1), a2 + hstep, voffA);
            PG8_WAIT_L(8); PG8_BAR; PG8_WAIT_L(0); PG8_MMA(0, 0, At, B0); PG8_BAR; PG8_SCHED;
            PG8_LDB(B1, 1, 1); PG8_STAGE(PG8_SB(1, 0), b3, voffB);
            PG8_BAR; PG8_WAIT_L(0); PG8_MMA(0, 1, At, B1); PG8_BAR;
            PG8_LDA(At, 1, 1); PG8_STAGE(PG8_SA(1, 0), a3, voffA);
            PG8_BAR; PG8_WAIT_L(0); PG8_MMA(1, 0, At, B0); PG8_BAR; PG8_SCHED;
            PG8_STAGE(PG8_SB(1, 1), b3 + hstep, voffB);
            PG8_WAIT_V(6); PG8_BAR; PG8_MMA(1, 1, At, B1); PG8_BAR;
            }
        }
        if constexpr (ALIGN_EPI) { if (wr == 0) PG8_BAR; }
        if constexpr (!Epi::AFTER_DRAIN) { E(acc, cur, wr, wc, fr, fq); S.done(cur); }
        if (!has_next) break;
#pragma unroll
        for (int a = 0; a < 2; ++a)
#pragma unroll
            for (int b = 0; b < 2; ++b)
#pragma unroll
                for (int m = 0; m < 4; ++m)
#pragma unroll
                    for (int n = 0; n < 2; ++n) acc[a][b][m][n] = (f32x4){0.f, 0.f, 0.f, 0.f};
        cur = nxt; cA = nA; cB = nB; ++ui;
        if constexpr (ALIGN_EPI) { if (wr == 1) PG8_BAR; }
    }
    PG8_WAIT_V(0);
    if constexpr (!ALIGN_EPI) { if (wr == 0) PG8_BAR; }
    PG8_BAR;
    if constexpr (Epi::AFTER_DRAIN) { E.fused(acc, cur, wr, wc, fr, fq, lds, wid, lane); S.done(cur); }
#undef PG8_SA
#undef PG8_SB
#undef PG8_STAGE
#undef PG8_LDA
#undef PG8_LDB
#undef PG8_MMA
#undef PG8_WAIT_V
#undef PG8_WAIT_L
#undef PG8_BAR
#undef PG8_SCHED
}
}
#define DI __device__ __forceinline__
#define LAS __attribute__((address_space(3)))
typedef unsigned short bf16;
typedef unsigned u32x4 __attribute__((ext_vector_type(4)));
typedef unsigned u32x2 __attribute__((ext_vector_type(2)));
typedef float f32x4 __attribute__((ext_vector_type(4)));
typedef float f32x16 __attribute__((ext_vector_type(16)));
typedef short bf16x8 __attribute__((ext_vector_type(8)));
typedef float f32x2_t __attribute__((ext_vector_type(2)));
typedef __bf16 bf16x2_t __attribute__((ext_vector_type(2)));
#define LDS_WAIT() asm volatile("s_waitcnt lgkmcnt(0)" ::: "memory")
#define MFMA32(a, b, c) __builtin_amdgcn_mfma_f32_32x32x16_bf16((a), (b), (c), 0, 0, 0)
#define MFMA16(a, b, c) __builtin_amdgcn_mfma_f32_16x16x32_bf16((a), (b), (c), 0, 0, 0)

DI unsigned pk2(float lo, float hi) { f32x2_t v = {lo, hi}; bf16x2_t b = __builtin_convertvector(v, bf16x2_t); return __builtin_bit_cast(unsigned, b); }
DI float bflo(unsigned u) { return __uint_as_float(u << 16); }
DI float bfhi(unsigned u) { return __uint_as_float(u & 0xffff0000u); }
DI float bf2f(bf16 h) { return __uint_as_float(((unsigned)h) << 16); }
DI bf16 f2bf(float f) { return (bf16)(pk2(f, 0.f) & 0xffffu); }
DI float wave_sum(float v) {
#pragma unroll
    for (int o = 1; o < 64; o <<= 1) v += __shfl_xor(v, o);
    return v;
}
DI float silu_f(float x) { return x * __builtin_amdgcn_rcpf(1.0f + __expf(-x)); }
DI int crow(int r, int hi) { return (r & 3) + 8 * (r >> 2) + 4 * hi; }
DI bf16x8 pack8(const f32x4& a, const f32x4& b) { u32x4 p; p.x = pk2(a[0], a[1]); p.y = pk2(a[2], a[3]); p.z = pk2(b[0], b[1]); p.w = pk2(b[2], b[3]); return __builtin_bit_cast(bf16x8, p); }

constexpr int NB = 8, T = 4096, M = NB * T, DM = 1024, FF = 2816;
constexpr float EPS = 1e-6f;
constexpr int NPH = 14;
constexpr int WAVE_LDS = 18944, LDS_BYTES = 8 * WAVE_LDS;

constexpr size_t MiB = 1u << 20;
constexpr size_t SZ_WGU = 5632ull * 1024 * 2, SZ_WD = 1024ull * 2816 * 2, SZ_WIN = 2560ull * 1024 * 2, SZ_WUQ = 768ull * 256 * 2, SZ_WKV = 1024ull * 128 * 2, SZ_WOUT = 1024ull * 1024 * 2;
constexpr size_t WS_W1GU = 0, WS_W1D = WS_W1GU + SZ_WGU, WS_WIN = WS_W1D + SZ_WD, WS_WUQ = WS_WIN + SZ_WIN, WS_WKV = WS_WUQ + SZ_WUQ, WS_WOUT = WS_WKV + SZ_WKV,
                 WS_W2GU = WS_WOUT + SZ_WOUT, WS_W2D = WS_W2GU + SZ_WGU, WS_ROWSQ = WS_W2D + SZ_WD, WS_GLAST = WS_ROWSQ + (size_t)M * 16 * 4, WS_BAR = WS_GLAST + 4096 * 4, WS_RS = WS_BAR + 32768, WS_P = WS_RS + 2 * (size_t)M * 4,
                 WS_Q = WS_P + 64 * MiB, WS_H = WS_Q + 64 * MiB, WS_G = WS_H + 177 * MiB, WS_END = WS_G + 4096ull * 40960;
static_assert(WS_END <= 512 * MiB, "workspace map exceeds the guaranteed 512 MiB");
static_assert((size_t)M * FF * 2 == 176 * MiB, "H region");
constexpr size_t P_CQN = 0, P_CKVN = 16 * MiB, P_MLAO = 24 * MiB;
constexpr size_t H_PS = 0, H_QKV = 64 * MiB, H_KB = 64 * MiB, H_VT = 112 * MiB, H_OG = 145 * MiB;
constexpr int VT_LD = M + 64;
static_assert(512ull * VT_LD * 2 <= 33 * MiB, "Vt slot");

struct Args { const void* in[25]; float* out; unsigned char* ws; int ph_lo, ph_hi; };

DI int wmap(int mode, int n) {
    switch (mode) {
        case 1: return (n >> 7) * 256 + (n & 127);
        case 2: return (n >> 7) * 256 + 128 + (n & 127);
        case 3: return n < 256 ? 512 + n : n < 384 ? 768 + (n - 256) : n < 416 ? 896 + (n - 384) : n < 1952 ? 1024 + (n - 416) : n < 1960 ? 928 + (n - 1952) : n < 1968 ? 936 + (n - 1960) : (n - 1968);
        case 4: { const int h = n >> 7, r = n & 127; return (r < 64 ? 0 : 512) + h * 64 + (r & 63); }
        default: return n;
    }
}
DI void transpose_item(const float* W, int K, int N, bf16* WT, int mode, LAS float* scr, int item, int lane, const float* gk = nullptr) {
    const float wsc = mode == 1 ? -1.4426950408889634f : mode == 2 ? -0.6931471805599453f : 1.0f;
    const int nblk = (N + 31) / 32, kb = item / nblk, nb = item % nblk, k0 = 64 * kb, n0 = 32 * nb;
    f32x4 ld[8];
#pragma unroll
    for (int it = 0; it < 8; ++it) { const int kk = it * 8 + (lane >> 3), n4 = 4 * (lane & 7);
        ld[it] = (n0 + n4 < N) ? *(const f32x4*)(W + (size_t)(k0 + kk) * N + n0 + n4) : (f32x4){0.f, 0.f, 0.f, 0.f}; }
#pragma unroll
    for (int it = 0; it < 8; ++it) { const int kk = it * 8 + (lane >> 3), n4 = 4 * (lane & 7); LAS float* d = scr + kk * 33 + n4;
        d[0] = ld[it][0]; d[1] = ld[it][1]; d[2] = ld[it][2]; d[3] = ld[it][3]; }
    LDS_WAIT();
    const int c = lane & 7;
    float gs[8];
    { f32x4 g0 = {1.f, 1.f, 1.f, 1.f}, g1 = g0; if (gk) { g0 = *(const f32x4*)(gk + k0 + 8 * c); g1 = *(const f32x4*)(gk + k0 + 8 * c + 4); }
      gs[0] = g0[0] * wsc; gs[1] = g0[1] * wsc; gs[2] = g0[2] * wsc; gs[3] = g0[3] * wsc; gs[4] = g1[0] * wsc; gs[5] = g1[1] * wsc; gs[6] = g1[2] * wsc; gs[7] = g1[3] * wsc; }
#pragma unroll
    for (int j = 0; j < 4; ++j) {
        const int n = (lane >> 3) + 8 * j; const LAS float* s = scr + (8 * c) * 33 + n;
        u32x4 o; o.x = pk2(s[0 * 33] * gs[0], s[1 * 33] * gs[1]); o.y = pk2(s[2 * 33] * gs[2], s[3 * 33] * gs[3]); o.z = pk2(s[4 * 33] * gs[4], s[5 * 33] * gs[5]); o.w = pk2(s[6 * 33] * gs[6], s[7 * 33] * gs[7]);
        if (n0 + n < N) *(u32x4*)(WT + (size_t)wmap(mode, n0 + n) * K + k0 + 8 * c) = o;
    }
    LDS_WAIT();
}
template <int NR> DI void rms_rows_to_bf16(const float* x, const float* g, bf16* o, int m0, int mstride, int lane) {
    f32x4 v[NR][4]; float s[NR];
#pragma unroll
    for (int r = 0; r < NR; ++r)
#pragma unroll
        for (int j = 0; j < 4; ++j) v[r][j] = __builtin_nontemporal_load((const f32x4*)(x + (size_t)(m0 + r * mstride) * DM + 4 * lane + 256 * j));
#pragma unroll
    for (int r = 0; r < NR; ++r) { s[r] = 0.f;
#pragma unroll
        for (int j = 0; j < 4; ++j) s[r] += (v[r][j][0] * v[r][j][0] + v[r][j][1] * v[r][j][1]) + (v[r][j][2] * v[r][j][2] + v[r][j][3] * v[r][j][3]); }
#pragma unroll
    for (int r = 0; r < NR; ++r) {
        const float rr = rsqrtf(wave_sum(s[r]) * (1.f / 1024.f) + EPS);
#pragma unroll
        for (int j = 0; j < 4; ++j) { const f32x4 gg = *(const f32x4*)(g + 4 * lane + 256 * j); const f32x4 ov = v[r][j] * rr * gg;
            u32x2 w; w.x = pk2(ov[0], ov[1]); w.y = pk2(ov[2], ov[3]); *(u32x2*)(o + (size_t)(m0 + r * mstride) * DM + 4 * lane + 256 * j) = w; }
    }
}
template <int NR, bool XIN_BF, bool XOUT_BF> DI void resid_rows(const void* xin_, void* xout_, const bf16* d, const float* rsq, float coef, const float* pg, const float* ng, bf16* xn, int m0, int mstride, int lane, float* rs_out = nullptr) {
    f32x4 xv[NR][4]; u32x2 dv[NR][4]; float ss[NR];
#pragma unroll
    for (int r = 0; r < NR; ++r) { const size_t m = (size_t)(m0 + r * mstride);
        ss[r] = lane < 16 ? rsq[m * 16 + lane] : 0.f;
#pragma unroll
        for (int j = 0; j < 4; ++j) { const int c = 4 * lane + 256 * j;
            if (XIN_BF) { const u32x2 t = __builtin_nontemporal_load((const u32x2*)((const bf16*)xin_ + m * DM + c)); xv[r][j] = (f32x4){bflo(t.x), bfhi(t.x), bflo(t.y), bfhi(t.y)}; }
            else xv[r][j] = __builtin_nontemporal_load((const f32x4*)((const float*)xin_ + m * DM + c));
            dv[r][j] = __builtin_nontemporal_load((const u32x2*)(d + m * DM + c)); } }
#pragma unroll
    for (int r = 0; r < NR; ++r) { const size_t m = (size_t)(m0 + r * mstride);
        const float rr = rsqrtf(wave_sum(ss[r]) * (1.f / 1024.f) + EPS) * coef; float s2 = 0.f;
#pragma unroll
        for (int j = 0; j < 4; ++j) { const int c = 4 * lane + 256 * j; const f32x4 gg = *(const f32x4*)(pg + c);
            const f32x4 df = {bflo(dv[r][j].x), bfhi(dv[r][j].x), bflo(dv[r][j].y), bfhi(dv[r][j].y)};
            xv[r][j] = xv[r][j] + df * rr * gg;
            if (XOUT_BF) { u32x2 w; w.x = pk2(xv[r][j][0], xv[r][j][1]); w.y = pk2(xv[r][j][2], xv[r][j][3]); *(u32x2*)((bf16*)xout_ + m * DM + c) = w; }
            else __builtin_nontemporal_store(xv[r][j], (f32x4*)((float*)xout_ + m * DM + c));
            s2 += (xv[r][j][0] * xv[r][j][0] + xv[r][j][1] * xv[r][j][1]) + (xv[r][j][2] * xv[r][j][2] + xv[r][j][3] * xv[r][j][3]); }
        if (rs_out) { const float r2 = rsqrtf(wave_sum(s2) * (1.f / 1024.f) + EPS); if (lane == 0) rs_out[m] = r2; }
        if (xn) {
            const float r2 = rsqrtf(wave_sum(s2) * (1.f / 1024.f) + EPS);
#pragma unroll
            for (int j = 0; j < 4; ++j) { const int c = 4 * lane + 256 * j; const f32x4 gg = *(const f32x4*)(ng + c); const f32x4 o = xv[r][j] * r2 * gg;
                u32x2 w; w.x = pk2(o[0], o[1]); w.y = pk2(o[2], o[3]); *(u32x2*)(xn + m * DM + c) = w; }
        }
    }
}
DI void rope_cs(int pos, int j, float& c, float& s) {
    const int jl = j & 3, jh = j >> 2;
    const double fb = jl == 0 ? 1.0 : jl == 1 ? 0.5623413251903491 : jl == 2 ? 0.31622776601683794 : 0.1778279410038923;
    const double fs = jh == 0 ? 1.0 : jh == 1 ? 0.1 : jh == 2 ? 0.01 : 0.001;
    double a = (double)pos * (fb * fs) * 0.15915494309189535;
    a -= __builtin_rint(a);
    const float fr = (float)a;
    c = __builtin_amdgcn_cosf(fr); s = __builtin_amdgcn_sinf(fr);
}
template <int NR> DI void e2_rows(const bf16* PS, const float* gq, const float* gkv, bf16* CQN, bf16* CKVN, int m0, int mstride, int lane) {
    u32x2 a[NR]; unsigned bq[NR];
#pragma unroll
    for (int r = 0; r < NR; ++r) { const bf16* ps = PS + (size_t)(m0 + r * mstride) * 1024; a[r] = *(const u32x2*)(ps + 512 + 4 * lane); bq[r] = *(const unsigned*)(ps + 768 + 2 * lane); }
    const f32x4 g = *(const f32x4*)(gq + 4 * lane); const float g0 = gkv[2 * lane], g1 = gkv[2 * lane + 1];
#pragma unroll
    for (int r = 0; r < NR; ++r) { const size_t m = (size_t)(m0 + r * mstride);
        f32x4 v = {bflo(a[r].x), bfhi(a[r].x), bflo(a[r].y), bfhi(a[r].y)};
        float rr = rsqrtf(wave_sum((v[0] * v[0] + v[1] * v[1]) + (v[2] * v[2] + v[3] * v[3])) * (1.f / 256.f) + EPS);
        v = v * rr * g;
        u32x2 w; w.x = pk2(v[0], v[1]); w.y = pk2(v[2], v[3]); *(u32x2*)(CQN + m * 256 + 4 * lane) = w;
        const float k0 = bflo(bq[r]), k1 = bfhi(bq[r]);
        rr = rsqrtf(wave_sum(k0 * k0 + k1 * k1) * (1.f / 128.f) + EPS);
        *(unsigned*)(CKVN + m * 128 + 2 * lane) = pk2(k0 * rr * g0, k1 * rr * g1); }
}
template <int NR> DI void kpe_rows(const bf16* PS, const int* positions, bf16* KB, int m0, int mstride, int lane) {
    const int j = lane & 15, hh = lane >> 4;
    bf16 a1[NR], a2[NR]; int pos[NR];
#pragma unroll
    for (int r = 0; r < NR; ++r) { const size_t m = (size_t)(m0 + r * mstride); a1[r] = PS[m * 1024 + 896 + j]; a2[r] = PS[m * 1024 + 912 + j]; pos[r] = positions[m]; }
#pragma unroll
    for (int r = 0; r < NR; ++r) { const size_t m = (size_t)(m0 + r * mstride);
        const float x1 = bf2f(a1[r]), x2 = bf2f(a2[r]);
        float c, s; rope_cs(pos[r], j, c, s);
        const bf16 o1 = f2bf(x1 * c - x2 * s), o2 = f2bf(x1 * s + x2 * c);
        bf16* krow = KB + m * 768;
        krow[hh * 96 + 64 + j] = o1; krow[hh * 96 + 80 + j] = o2;
        krow[(hh + 4) * 96 + 64 + j] = o1; krow[(hh + 4) * 96 + 80 + j] = o2; }
}
template <int NR> DI void mix_rows(const bf16* MLA, const bf16* OGp, const bf16* GATE, const float* g_mla, const float* g_gdn, bf16* OUT, int m0, int mstride, int lane) {
    u32x4 am[NR], ao[NR], ag[NR];
#pragma unroll
    for (int r = 0; r < NR; ++r) { const size_t m = (size_t)(m0 + r * mstride);
        am[r] = *(const u32x4*)(MLA + m * 512 + 8 * lane); ao[r] = *(const u32x4*)(OGp + m * 512 + 8 * lane); ag[r] = *(const u32x4*)(GATE + m * 1024 + 8 * lane); }
    const f32x4 gm0 = *(const f32x4*)(g_mla + 8 * lane), gm1 = *(const f32x4*)(g_mla + 8 * lane + 4);
    const int e0 = 8 * (lane & 7);
    const f32x4 gd0 = *(const f32x4*)(g_gdn + e0), gd1 = *(const f32x4*)(g_gdn + e0 + 4);
    const float gm[8] = {gm0[0], gm0[1], gm0[2], gm0[3], gm1[0], gm1[1], gm1[2], gm1[3]};
    const float gd[8] = {gd0[0], gd0[1], gd0[2], gd0[3], gd1[0], gd1[1], gd1[2], gd1[3]};
#pragma unroll
    for (int r = 0; r < NR; ++r) { const size_t m = (size_t)(m0 + r * mstride);
        {
            const u32x4 a = am[r];
            float v[8] = {bflo(a.x), bfhi(a.x), bflo(a.y), bfhi(a.y), bflo(a.z), bfhi(a.z), bflo(a.w), bfhi(a.w)};
            float s2 = 0.f;
#pragma unroll
            for (int i = 0; i < 8; ++i) s2 += v[i] * v[i];
            const float rr = rsqrtf(wave_sum(s2) * (1.f / 512.f) + EPS);
            u32x4 w; w.x = pk2(v[0] * rr * gm[0], v[1] * rr * gm[1]); w.y = pk2(v[2] * rr * gm[2], v[3] * rr * gm[3]); w.z = pk2(v[4] * rr * gm[4], v[5] * rr * gm[5]); w.w = pk2(v[6] * rr * gm[6], v[7] * rr * gm[7]);
            *(u32x4*)(OUT + m * 1024 + 8 * lane) = w;
        }
        {
            const u32x4 a = ao[r], gt = ag[r];
            float v[8] = {bflo(a.x), bfhi(a.x), bflo(a.y), bfhi(a.y), bflo(a.z), bfhi(a.z), bflo(a.w), bfhi(a.w)};
            float gv[8] = {bflo(gt.x), bfhi(gt.x), bflo(gt.y), bfhi(gt.y), bflo(gt.z), bfhi(gt.z), bflo(gt.w), bfhi(gt.w)};
            float s2 = 0.f;
#pragma unroll
            for (int i = 0; i < 8; ++i) s2 += v[i] * v[i];
            s2 += __shfl_xor(s2, 1); s2 += __shfl_xor(s2, 2); s2 += __shfl_xor(s2, 4);
            const float rr = rsqrtf(s2 * (1.f / 64.f) + EPS);
            float o[8];
#pragma unroll
            for (int i = 0; i < 8; ++i) o[i] = v[i] * rr * gd[i] * silu_f(gv[i]);
            u32x4 w; w.x = pk2(o[0], o[1]); w.y = pk2(o[2], o[3]); w.z = pk2(o[4], o[5]); w.w = pk2(o[6], o[7]);
            *(u32x4*)(OUT + m * 1024 + 512 + 8 * lane) = w;
        }
    }
}

template <int NR> DI void mla_norm_rows(bf16* A, const float* g_mla, int m0, int mstride, int lane) {
    u32x4 am[NR];
#pragma unroll
    for (int r = 0; r < NR; ++r) am[r] = *(const u32x4*)(A + (size_t)(m0 + r * mstride) * 1024 + 8 * lane);
    const f32x4 gm0 = *(const f32x4*)(g_mla + 8 * lane), gm1 = *(const f32x4*)(g_mla + 8 * lane + 4);
    const float gm[8] = {gm0[0], gm0[1], gm0[2], gm0[3], gm1[0], gm1[1], gm1[2], gm1[3]};
#pragma unroll
    for (int r = 0; r < NR; ++r) {
        const u32x4 a = am[r];
        float v[8] = {bflo(a.x), bfhi(a.x), bflo(a.y), bfhi(a.y), bflo(a.z), bfhi(a.z), bflo(a.w), bfhi(a.w)};
        float s2 = 0.f;
#pragma unroll
        for (int i = 0; i < 8; ++i) s2 += v[i] * v[i];
        const float rr = rsqrtf(wave_sum(s2) * (1.f / 512.f) + EPS);
        u32x4 w; w.x = pk2(v[0] * rr * gm[0], v[1] * rr * gm[1]); w.y = pk2(v[2] * rr * gm[2], v[3] * rr * gm[3]); w.z = pk2(v[4] * rr * gm[4], v[5] * rr * gm[5]); w.w = pk2(v[6] * rr * gm[6], v[7] * rr * gm[7]);
        *(u32x4*)(A + (size_t)(m0 + r * mstride) * 1024 + 8 * lane) = w;
    }
}
DI void conv_row(const bf16* qkv, int row0, int n, int coff, const float* cw, LAS unsigned char* R, LAS unsigned char* HX, int lane, float (&y)[64]) {
    const __attribute__((address_space(4))) float* cw4 = (const __attribute__((address_space(4))) float*)(uintptr_t)cw;
#pragma unroll
    for (int it = 0; it < 8; ++it) { const int r = it * 8 + (lane >> 3), c8 = lane & 7;
        const u32x4 v = *(const u32x4*)(qkv + (size_t)(row0 + r) * 1536 + coff + c8 * 8); *(LAS u32x4*)(R + r * 144 + c8 * 16) = v; }
    {
        const int hr = lane >> 3, c8 = lane & 7;
        u32x4 v = {0u, 0u, 0u, 0u};
        if (lane < 24 && n > 0) v = *(const u32x4*)(qkv + (size_t)(row0 - 3 + hr) * 1536 + coff + c8 * 8);
        if (lane < 24) *(LAS u32x4*)(HX + hr * 144 + c8 * 16) = v;
    }
    LDS_WAIT();
    const LAS unsigned char* tp[4];
#pragma unroll
    for (int j = 0; j < 4; ++j) { const int tr = lane - 3 + j; tp[j] = tr >= 0 ? (const LAS unsigned char*)(R + tr * 144) : (const LAS unsigned char*)(HX + (tr + 3) * 144); }
#pragma unroll
    for (int c8 = 0; c8 < 8; ++c8) {
        float acc[8];
#pragma unroll
        for (int i = 0; i < 8; ++i) acc[i] = 0.f;
#pragma unroll
        for (int j = 0; j < 4; ++j) {
            const u32x4 xv = *(const LAS u32x4*)(tp[j] + c8 * 16);
            float w[8];
#pragma unroll
            for (int i = 0; i < 8; ++i) w[i] = cw4[j * 1536 + c8 * 8 + i];
            acc[0] += w[0] * bflo(xv.x); acc[1] += w[1] * bfhi(xv.x); acc[2] += w[2] * bflo(xv.y); acc[3] += w[3] * bfhi(xv.y);
            acc[4] += w[4] * bflo(xv.z); acc[5] += w[5] * bfhi(xv.z); acc[6] += w[6] * bflo(xv.w); acc[7] += w[7] * bfhi(xv.w);
        }
#pragma unroll
        for (int i = 0; i < 8; ++i) y[c8 * 8 + i] = silu_f(acc[i]);
    }
    LDS_WAIT();
}
DI void copy_out(const LAS unsigned char* R, bf16* g, int lane) {
#pragma unroll
    for (int it = 0; it < 8; ++it) { const int r = it * 8 + (lane >> 3), c8 = lane & 7; *(u32x4*)(g + r * 64 + c8 * 8) = *(const LAS u32x4*)(R + r * 144 + c8 * 16); }
}
DI void gdn_prep_unit(int uid, const bf16* qkv, const bf16* psmall, const float* convw, const float* a_log, const float* dt_bias,
                      unsigned char* G, float* glast, LAS unsigned char* wl, int lane) {
    asm volatile("" : "+v"(lane));
    asm volatile("" : "+s"(uid));
    const int h = uid & 7, n = (uid >> 3) & 63, b = uid >> 9;
    const int row0 = b * T + 64 * n;
    const int r32 = lane & 31, hi = lane >> 5;
    unsigned char* Gu = G + (size_t)uid * 40960;
    bf16* Wn = (bf16*)Gu; bf16* QD = Wn + 4096; bf16* AT = QD + 4096; bf16* KDT = AT + 4096; bf16* UT = KDT + 4096;
    LAS unsigned char* R0 = wl; LAS unsigned char* R1 = wl + 9216; LAS unsigned char* HX = wl + 18432;
    const bf16* pr = psmall + (size_t)(row0 + lane) * 1024;
    const float xa = bf2f(pr[928 + h]) + dt_bias[h], xb = bf2f(pr[936 + h]);
    const float sp = xa > 20.f ? xa : log1pf(__expf(xa));
    const float g = -__expf(a_log[h]) * sp;
    const float beta = 1.f / (1.f + __expf(-xb));
    float gc = g;
#pragma unroll
    for (int o = 1; o < 64; o <<= 1) { const float v = __shfl_up(gc, o); if (lane >= o) gc += v; }
    const float gl = __shfl(gc, 63);
    const float eg = __expf(gc);
#pragma unroll 1
    for (int mt = 0; mt < 3; ++mt) {
        const int coff = (mt == 0 ? 1024 : mt == 1 ? 512 : 0) + h * 64;
        LAS unsigned char* R = mt == 2 ? R1 : R0;
        float y[64]; conv_row(qkv, row0, n, coff, convw + coff, R, HX, lane, y);
        float ss = 0.f;
#pragma unroll
        for (int i = 0; i < 64; ++i) ss += y[i] * y[i];
        const float rn = mt == 0 ? beta : rsqrtf(ss + EPS) * (mt == 2 ? 0.125f : 1.f);
#pragma unroll
        for (int c8 = 0; c8 < 8; ++c8) {
            u32x4 w;
            w.x = pk2(y[8 * c8] * rn, y[8 * c8 + 1] * rn); w.y = pk2(y[8 * c8 + 2] * rn, y[8 * c8 + 3] * rn); w.z = pk2(y[8 * c8 + 4] * rn, y[8 * c8 + 5] * rn); w.w = pk2(y[8 * c8 + 6] * rn, y[8 * c8 + 7] * rn);
            *(LAS u32x4*)(R + lane * 144 + c8 * 16) = w;
        }
        LDS_WAIT();
        if (mt == 2) {
#pragma unroll
            for (int it = 0; it < 8; ++it) { const int r = it * 8 + (lane >> 3), c8 = lane & 7; const u32x4 v = *(const LAS u32x4*)(R + r * 144 + c8 * 16); const float er = __shfl(eg, r);
                u32x4 w; w.x = pk2(bflo(v.x) * er, bfhi(v.x) * er); w.y = pk2(bflo(v.y) * er, bfhi(v.y) * er); w.z = pk2(bflo(v.z) * er, bfhi(v.z) * er); w.w = pk2(bflo(v.w) * er, bfhi(v.w) * er);
                *(u32x4*)(QD + r * 64 + c8 * 8) = w; }
        } else copy_out(R, mt == 0 ? UT : Wn, lane);
        asm volatile("" ::: "memory");
    }
    LDS_WAIT(); asm volatile("" ::: "memory");
    bf16x8 kf[2][4];
#pragma unroll
    for (int rb = 0; rb < 2; ++rb)
#pragma unroll
        for (int ks = 0; ks < 4; ++ks) kf[rb][ks] = *(const LAS bf16x8*)(R0 + (32 * rb + r32) * 144 + (16 * ks + 8 * hi) * 2);
    {
        bf16x8 qf[2][4];
#pragma unroll
        for (int rb = 0; rb < 2; ++rb)
#pragma unroll
            for (int ks = 0; ks < 4; ++ks) qf[rb][ks] = *(const LAS bf16x8*)(R1 + (32 * rb + r32) * 144 + (16 * ks + 8 * hi) * 2);
        f32x16 d00 = {}, d01 = {}, d11 = {};
#pragma unroll
        for (int ks = 0; ks < 4; ++ks) { d00 = MFMA32(kf[0][ks], qf[0][ks], d00); d01 = MFMA32(kf[0][ks], qf[1][ks], d01); d11 = MFMA32(kf[1][ks], qf[1][ks], d11); }
        LDS_WAIT(); asm volatile("" ::: "memory");
#pragma unroll
        for (int blk = 0; blk < 4; ++blk) {
            const int jb = blk >> 1, ib = (blk == 1 || blk == 2) ? 1 : 0;
            const int i = 32 * ib + r32; const float gci = __shfl(gc, i);
#pragma unroll
            for (int g4 = 0; g4 < 4; ++g4) {
                const int j0 = 32 * jb + 8 * g4 + 4 * hi; float v[4];
#pragma unroll
                for (int e = 0; e < 4; ++e) {
                    const int j = j0 + e; const float gcj = __shfl(gc, j);
                    const float dv = blk == 0 ? d00[4 * g4 + e] : blk == 1 ? d01[4 * g4 + e] : blk == 2 ? d11[4 * g4 + e] : 0.f;
                    v[e] = (j <= i) ? dv * __expf(gci - gcj) : 0.f;
                }
                u32x2 w; w.x = pk2(v[0], v[1]); w.y = pk2(v[2], v[3]); *(LAS u32x2*)(R1 + i * 144 + j0 * 2) = w;
            }
        }
        LDS_WAIT();
        copy_out(R1, AT, lane);
    }
    LDS_WAIT(); asm volatile("" ::: "memory");
    {
        f32x16 e00 = {}, e10 = {}, e11 = {};
#pragma unroll
        for (int ks = 0; ks < 4; ++ks) { e00 = MFMA32(kf[0][ks], kf[0][ks], e00); e10 = MFMA32(kf[1][ks], kf[0][ks], e10); e11 = MFMA32(kf[1][ks], kf[1][ks], e11); }
#pragma unroll
        for (int blk = 0; blk < 3; ++blk) {
            const int ab = blk >= 1 ? 1 : 0, bb = blk == 2 ? 1 : 0;
            const int bcol = 32 * bb + r32; const float gcb = __shfl(gc, bcol);
#pragma unroll
            for (int g4 = 0; g4 < 4; ++g4) {
                const int a0 = 32 * ab + 8 * g4 + 4 * hi; f32x4 v;
#pragma unroll
                for (int e = 0; e < 4; ++e) {
                    const int a = a0 + e; const float gca = __shfl(gc, a), ba = __shfl(beta, a);
                    const float dv = blk == 0 ? e00[4 * g4 + e] : blk == 1 ? e10[4 * g4 + e] : e11[4 * g4 + e];
                    v[e] = (a > bcol) ? dv * ba * __expf(gca - gcb) : 0.f;
                }
                *(LAS f32x4*)(R0 + (bcol * 64 + a0) * 4) = v;
            }
        }
    }
    LDS_WAIT();
    u32x4 kp[8];
#pragma unroll
    for (int it = 0; it < 8; ++it) { const int r = it * 8 + (lane >> 3), c8 = lane & 7; kp[it] = *(const u32x4*)(Wn + r * 64 + c8 * 8); }
    {
        const int blk = lane >> 5, il = lane & 31;
        const LAS unsigned char* LTb = R0 + blk * 8320;
        float Tr[32];
#pragma unroll
        for (int c = 31; c >= 0; --c) {
            float acc = (il == c) ? 1.f : 0.f;
#pragma unroll
            for (int j4 = ((c + 1) / 4) * 4; j4 < 32; j4 += 4) {
                const f32x4 l = *(const LAS f32x4*)(LTb + (c * 64 + j4) * 4);
#pragma unroll
                for (int jj = 0; jj < 4; ++jj) if (j4 + jj > c) acc -= Tr[j4 + jj] * l[jj];
            }
            Tr[c] = acc;
            if ((c & 3) == 0) asm volatile("" ::: "memory");
        }
        bf16x8 a21[2];
#pragma unroll
        for (int ks = 0; ks < 2; ++ks) {
            float t[8];
#pragma unroll
            for (int i = 0; i < 8; ++i) t[i] = *(const LAS float*)(R0 + ((16 * ks + 8 * hi + i) * 64 + 32 + r32) * 4);
            u32x4 p; p.x = pk2(t[0], t[1]); p.y = pk2(t[2], t[3]); p.z = pk2(t[4], t[5]); p.w = pk2(t[6], t[7]); a21[ks] = __builtin_bit_cast(bf16x8, p);
        }
        LDS_WAIT();
#pragma unroll
        for (int c8 = 0; c8 < 4; ++c8) {
            u32x4 w; w.x = pk2(Tr[8 * c8], Tr[8 * c8 + 1]); w.y = pk2(Tr[8 * c8 + 2], Tr[8 * c8 + 3]); w.z = pk2(Tr[8 * c8 + 4], Tr[8 * c8 + 5]); w.w = pk2(Tr[8 * c8 + 6], Tr[8 * c8 + 7]);
            *(LAS u32x4*)(R0 + lane * 144 + (32 * blk + 8 * c8) * 2) = w;
            *(LAS u32x4*)(R0 + lane * 144 + (32 * (1 - blk) + 8 * c8) * 2) = (u32x4){0u, 0u, 0u, 0u};
        }
        LDS_WAIT();
        f32x16 X = {};
#pragma unroll
        for (int ks = 0; ks < 2; ++ks) {
            unsigned short t[8];
#pragma unroll
            for (int i = 0; i < 8; ++i) t[i] = *(const LAS unsigned short*)(R0 + (16 * ks + 8 * hi + i) * 144 + r32 * 2);
            u32x4 p; p.x = t[0] | ((unsigned)t[1] << 16); p.y = t[2] | ((unsigned)t[3] << 16); p.z = t[4] | ((unsigned)t[5] << 16); p.w = t[6] | ((unsigned)t[7] << 16);
            X = MFMA32(a21[ks], __builtin_bit_cast(bf16x8, p), X);
        }
        f32x16 Y = {};
#pragma unroll
        for (int sstep = 0; sstep < 2; ++sstep) {
            u32x4 xb; xb.x = pk2(X[8 * sstep], X[8 * sstep + 1]); xb.y = pk2(X[8 * sstep + 2], X[8 * sstep + 3]); xb.z = pk2(X[8 * sstep + 4], X[8 * sstep + 5]); xb.w = pk2(X[8 * sstep + 6], X[8 * sstep + 7]);
            const LAS unsigned char* ap = R0 + (32 + r32) * 144 + (32 + 16 * sstep + 4 * hi) * 2;
            const u32x2 lo = *(const LAS u32x2*)ap, hi2 = *(const LAS u32x2*)(ap + 16);
            u32x4 av = {lo.x, lo.y, hi2.x, hi2.y};
            Y = MFMA32(__builtin_bit_cast(bf16x8, av), __builtin_bit_cast(bf16x8, xb), Y);
        }
        LDS_WAIT();
#pragma unroll
        for (int r = 0; r < 16; ++r) *(LAS bf16*)(R0 + (32 + crow(r, hi)) * 144 + r32 * 2) = f2bf(-Y[r]);
    }
    LDS_WAIT();
    {
        const float scl = beta * eg;
#pragma unroll
        for (int it = 0; it < 8; ++it) { const int r = it * 8 + (lane >> 3), c8 = lane & 7; const float sr = __shfl(scl, r);
            LAS unsigned char* d = R1 + (8 * c8) * 144 + r * 2;
            *(LAS bf16*)(d) = f2bf(bflo(kp[it].x) * sr); *(LAS bf16*)(d + 144) = f2bf(bfhi(kp[it].x) * sr); *(LAS bf16*)(d + 288) = f2bf(bflo(kp[it].y) * sr); *(LAS bf16*)(d + 432) = f2bf(bfhi(kp[it].y) * sr);
            *(LAS bf16*)(d + 576) = f2bf(bflo(kp[it].z) * sr); *(LAS bf16*)(d + 720) = f2bf(bfhi(kp[it].z) * sr); *(LAS bf16*)(d + 864) = f2bf(bflo(kp[it].w) * sr); *(LAS bf16*)(d + 1008) = f2bf(bfhi(kp[it].w) * sr); }
    }
    LDS_WAIT();
    u32x4 vp[8];
#pragma unroll
    for (int it = 0; it < 8; ++it) { const int r = it * 8 + (lane >> 3), c8 = lane & 7; vp[it] = *(const u32x4*)(UT + r * 64 + c8 * 8); }
    bf16x8 tf[2][4];
#pragma unroll
    for (int rb = 0; rb < 2; ++rb)
#pragma unroll
        for (int ks = 0; ks < 4; ++ks) tf[rb][ks] = *(const LAS bf16x8*)(R0 + (32 * rb + r32) * 144 + (16 * ks + 8 * hi) * 2);
    {
        bf16x8 rt[2][4];
#pragma unroll
        for (int db = 0; db < 2; ++db)
#pragma unroll
            for (int ks = 0; ks < 4; ++ks) rt[db][ks] = *(const LAS bf16x8*)(R1 + (32 * db + r32) * 144 + (16 * ks + 8 * hi) * 2);
        LDS_WAIT(); asm volatile("" ::: "memory");
#pragma unroll
        for (int db = 0; db < 2; ++db)
#pragma unroll
            for (int ib = 0; ib < 2; ++ib) {
                f32x16 d = {};
#pragma unroll
                for (int ks = 0; ks < 4; ++ks) if (ib == 1 || ks < 2) d = MFMA32(rt[db][ks], tf[ib][ks], d);
                const int i = 32 * ib + r32;
#pragma unroll
                for (int g4 = 0; g4 < 4; ++g4) { const int d0 = 32 * db + 8 * g4 + 4 * hi;
                    u32x2 w; w.x = pk2(-d[4 * g4], -d[4 * g4 + 1]); w.y = pk2(-d[4 * g4 + 2], -d[4 * g4 + 3]); *(LAS u32x2*)(R1 + i * 144 + d0 * 2) = w; }
            }
        LDS_WAIT();
        copy_out(R1, Wn, lane);
    }
    LDS_WAIT(); asm volatile("" ::: "memory");
    {
        const float kd = __expf(gl - gc);
#pragma unroll
        for (int it = 0; it < 8; ++it) { const int r = it * 8 + (lane >> 3), c8 = lane & 7; const float sr = __shfl(kd, r);
            LAS unsigned char* d = R1 + (8 * c8) * 144 + r * 2;
            *(LAS bf16*)(d) = f2bf(bflo(kp[it].x) * sr); *(LAS bf16*)(d + 144) = f2bf(bfhi(kp[it].x) * sr); *(LAS bf16*)(d + 288) = f2bf(bflo(kp[it].y) * sr); *(LAS bf16*)(d + 432) = f2bf(bfhi(kp[it].y) * sr);
            *(LAS bf16*)(d + 576) = f2bf(bflo(kp[it].z) * sr); *(LAS bf16*)(d + 720) = f2bf(bfhi(kp[it].z) * sr); *(LAS bf16*)(d + 864) = f2bf(bflo(kp[it].w) * sr); *(LAS bf16*)(d + 1008) = f2bf(bfhi(kp[it].w) * sr); }
        LDS_WAIT();
        copy_out(R1, KDT, lane);
    }
    LDS_WAIT(); asm volatile("" ::: "memory");
    {
#pragma unroll
        for (int it = 0; it < 8; ++it) { const int r = it * 8 + (lane >> 3), c8 = lane & 7;
            LAS unsigned char* d = R1 + (8 * c8) * 144 + r * 2;
            *(LAS bf16*)(d) = (bf16)(vp[it].x & 0xffffu); *(LAS bf16*)(d + 144) = (bf16)(vp[it].x >> 16); *(LAS bf16*)(d + 288) = (bf16)(vp[it].y & 0xffffu); *(LAS bf16*)(d + 432) = (bf16)(vp[it].y >> 16);
            *(LAS bf16*)(d + 576) = (bf16)(vp[it].z & 0xffffu); *(LAS bf16*)(d + 720) = (bf16)(vp[it].z >> 16); *(LAS bf16*)(d + 864) = (bf16)(vp[it].w & 0xffffu); *(LAS bf16*)(d + 1008) = (bf16)(vp[it].w >> 16); }
        LDS_WAIT();
        bf16x8 rt[2][4];
#pragma unroll
        for (int eb = 0; eb < 2; ++eb)
#pragma unroll
            for (int ks = 0; ks < 4; ++ks) rt[eb][ks] = *(const LAS bf16x8*)(R1 + (32 * eb + r32) * 144 + (16 * ks + 8 * hi) * 2);
        LDS_WAIT(); asm volatile("" ::: "memory");
#pragma unroll
        for (int eb = 0; eb < 2; ++eb)
#pragma unroll
            for (int ib = 0; ib < 2; ++ib) {
                f32x16 d = {};
#pragma unroll
                for (int ks = 0; ks < 4; ++ks) if (ib == 1 || ks < 2) d = MFMA32(tf[ib][ks], rt[eb][ks], d);
                const int e = 32 * eb + r32;
#pragma unroll
                for (int g4 = 0; g4 < 4; ++g4) { const int i0 = 32 * ib + 8 * g4 + 4 * hi;
                    u32x2 w; w.x = pk2(d[4 * g4], d[4 * g4 + 1]); w.y = pk2(d[4 * g4 + 2], d[4 * g4 + 3]); *(LAS u32x2*)(R1 + e * 144 + i0 * 2) = w; }
            }
        LDS_WAIT();
        copy_out(R1, UT, lane);
    }
    if (lane == 0) glast[uid] = __expf(gl);
    LDS_WAIT();
}
DI bf16x8 frag_a16(const LAS unsigned char* Mat, int mb, int ks, int m16, int q4) {
    const LAS unsigned char* p = Mat + (16 * mb + m16) * 144 + (32 * ks + 4 * q4) * 2;
    const u32x2 lo = *(const LAS u32x2*)p, hi = *(const LAS u32x2*)(p + 32);
    u32x4 v = {lo.x, lo.y, hi.x, hi.y}; return __builtin_bit_cast(bf16x8, v);
}
DI void gdn_scan(int b, int h, const unsigned char* G, const float* glast, const bf16* PSg, const float* g_gdn, bf16* MIXA, LAS unsigned char* lds, int tid) {
    const int wave = __builtin_amdgcn_readfirstlane(tid >> 6), lane = tid & 63, m16 = lane & 15, q4 = lane >> 4;
    const int prow = tid >> 3, pc = tid & 7;
    const int e = 16 * (wave & 3) + m16;
    f32x4 S[4];
#pragma unroll
    for (int i = 0; i < 4; ++i) S[i] = (f32x4){0.f, 0.f, 0.f, 0.f};
    u32x4 pA[4], pB[4]; u32x2 un[4]; float gln; u32x4 gt[2];
    const unsigned char* G0 = G + (size_t)(b * 512 + h) * 40960;
    const int fr0 = (tid & 255) >> 3, fc8 = tid & 7;
    float gd[8];
    { const f32x4 g0 = *(const f32x4*)(g_gdn + 8 * fc8), g1 = *(const f32x4*)(g_gdn + 8 * fc8 + 4); gd[0] = g0[0]; gd[1] = g0[1]; gd[2] = g0[2]; gd[3] = g0[3]; gd[4] = g1[0]; gd[5] = g1[1]; gd[6] = g1[2]; gd[7] = g1[3]; }
#define SC_ISSUE(P, n) do { const int nn_ = (n) < 64 ? (n) : 63; const unsigned char* Gn_ = G0 + (size_t)nn_ * (8 * 40960); _Pragma("unroll") for (int mt = 0; mt < 4; ++mt) P[mt] = *(const u32x4*)(Gn_ + mt * 8192 + tid * 16); } while (0)
#define SC_COMMIT(P, stage) do { LAS unsigned char* nb_ = lds + (stage) * 36864; _Pragma("unroll") for (int mt = 0; mt < 4; ++mt) *(LAS u32x4*)(nb_ + mt * 9216 + prow * 144 + pc * 16) = P[mt]; } while (0)
#define SC_UNEXT(n) do { const int nn_ = (n) < 64 ? (n) : 63; const bf16* UT_ = (const bf16*)(G0 + (size_t)nn_ * (8 * 40960) + 32768); _Pragma("unroll") for (int mb = 0; mb < 4; ++mb) un[mb] = *(const u32x2*)(UT_ + e * 64 + 16 * mb + 4 * q4); gln = glast[(b * 64 + nn_) * 8 + h]; } while (0)
#define SC_GATE(n) do { const int nn_ = (n) < 64 ? (n) : 63; _Pragma("unroll") for (int pp_ = 0; pp_ < 2; ++pp_) gt[pp_] = *(const u32x4*)(PSg + (size_t)(b * T + 64 * nn_ + fr0 + 32 * pp_) * 1024 + h * 64 + 8 * fc8); } while (0)
#define SC_FLUSH(n, stage) do { if (wave >= 4) { _Pragma("unroll") for (int pp_ = 0; pp_ < 2; ++pp_) { const int r_ = fr0 + 32 * pp_; \
        const u32x4 a_ = *(const LAS u32x4*)(lds + 73728 + (stage) * 9216 + r_ * 144 + fc8 * 16); const u32x4 g_ = gt[pp_]; \
        float v_[8] = {bflo(a_.x), bfhi(a_.x), bflo(a_.y), bfhi(a_.y), bflo(a_.z), bfhi(a_.z), bflo(a_.w), bfhi(a_.w)}; \
        float gv_[8] = {bflo(g_.x), bfhi(g_.x), bflo(g_.y), bfhi(g_.y), bflo(g_.z), bfhi(g_.z), bflo(g_.w), bfhi(g_.w)}; \
        float s2_ = 0.f; _Pragma("unroll") for (int i_ = 0; i_ < 8; ++i_) s2_ += v_[i_] * v_[i_]; \
        s2_ += __shfl_xor(s2_, 1); s2_ += __shfl_xor(s2_, 2); s2_ += __shfl_xor(s2_, 4); \
        const float rr_ = rsqrtf(s2_ * (1.f / 64.f) + EPS); float o_[8]; \
        _Pragma("unroll") for (int i_ = 0; i_ < 8; ++i_) o_[i_] = v_[i_] * rr_ * gd[i_] * silu_f(gv_[i_]); \
        u32x4 w_; w_.x = pk2(o_[0], o_[1]); w_.y = pk2(o_[2], o_[3]); w_.z = pk2(o_[4], o_[5]); w_.w = pk2(o_[6], o_[7]); \
        *(u32x4*)(MIXA + (size_t)(b * T + 64 * (n) + r_) * 1024 + 512 + h * 64 + 8 * fc8) = w_; } } } while (0)
#define SC_COMPUTE(n, stage) do { \
        f32x4 vn[4]; _Pragma("unroll") for (int mb = 0; mb < 4; ++mb) vn[mb] = (f32x4){bflo(un[mb].x), bfhi(un[mb].x), bflo(un[mb].y), bfhi(un[mb].y)}; \
        const float gl = gln; \
        SC_UNEXT((n) + 1);        \
        if (wave < 4) { \
        const LAS unsigned char* base = lds + (stage) * 36864; \
        bf16x8 bS[2], bV[2]; bS[0] = pack8(S[0], S[1]); bS[1] = pack8(S[2], S[3]); \
        _Pragma("unroll") for (int mb = 0; mb < 4; ++mb) _Pragma("unroll") for (int ks = 0; ks < 2; ++ks) vn[mb] = MFMA16(frag_a16(base, mb, ks, m16, q4), bS[ks], vn[mb]); \
        bV[0] = pack8(vn[0], vn[1]); bV[1] = pack8(vn[2], vn[3]); \
        _Pragma("unroll") for (int mb = 0; mb < 4; ++mb) { f32x4 o = {0.f, 0.f, 0.f, 0.f}; \
            _Pragma("unroll") for (int ks = 0; ks < 2; ++ks) { o = MFMA16(frag_a16(base + 9216, mb, ks, m16, q4), bS[ks], o); o = MFMA16(frag_a16(base + 18432, mb, ks, m16, q4), bV[ks], o); } \
            LAS unsigned char* op = lds + 73728 + (stage) * 9216 + (16 * mb + 4 * q4) * 144 + e * 2;     \
            *(LAS bf16*)(op) = f2bf(o[0]); *(LAS bf16*)(op + 144) = f2bf(o[1]); *(LAS bf16*)(op + 288) = f2bf(o[2]); *(LAS bf16*)(op + 432) = f2bf(o[3]); } \
        _Pragma("unroll") for (int mb = 0; mb < 4; ++mb) { S[mb] = S[mb] * gl; \
            _Pragma("unroll") for (int ks = 0; ks < 2; ++ks) S[mb] = MFMA16(frag_a16(base + 27648, mb, ks, m16, q4), bV[ks], S[mb]); } } } while (0)
    SC_ISSUE(pA, 0); SC_ISSUE(pB, 1);
    SC_UNEXT(0);
    SC_COMMIT(pA, 0);
    __syncthreads();
    for (int n = 0; n < 64; n += 2) {
        SC_ISSUE(pA, n + 2);
        if (n > 0) SC_FLUSH(n - 1, 1);
        SC_GATE(n);
        SC_COMPUTE(n, 0);
        SC_COMMIT(pB, 1);
        __syncthreads();
        SC_ISSUE(pB, n + 3);
        SC_FLUSH(n, 0);
        SC_GATE(n + 1);
        SC_COMPUTE(n + 1, 1);
        SC_COMMIT(pA, 0);
        __syncthreads();
    }
    SC_FLUSH(63, 1);
    __syncthreads();
#undef SC_ISSUE
#undef SC_COMMIT
#undef SC_UNEXT
#undef SC_GATE
#undef SC_FLUSH
#undef SC_COMPUTE
}
constexpr int AT_KS = 13312, AT_STAGE = 22016;
DI float max3f(float a, float b, float c) { float r; asm("v_max3_f32 %0, %1, %2, %3" : "=v"(r) : "v"(a), "v"(b), "v"(c)); return r; }
DI float max2f(float a, float b) { float r; asm("v_max_f32_e32 %0, %1, %2" : "=v"(r) : "v"(a), "v"(b)); return r; }
constexpr float AT_THR = 6.0f;
DI void attn_tile(bool MASK, const LAS unsigned char* Ks, const LAS unsigned char* Vs, const bf16x8 (&qr)[6], f32x16& negm, float& mrun, float& lrun, f32x16& o0, f32x16& o1,
                                       int kv0, int qrow, int r32, int hi) {
    f32x16 p0, p1;
    __builtin_amdgcn_s_setprio(1);
    {
        const bf16x8 a0 = *(const LAS bf16x8*)(Ks + r32 * 208 + hi * 16);
        const bf16x8 a1 = *(const LAS bf16x8*)(Ks + (32 + r32) * 208 + hi * 16);
        p0 = MFMA32(a0, qr[0], negm); p1 = MFMA32(a1, qr[0], negm);
    }
#pragma unroll
    for (int d0 = 1; d0 < 6; ++d0) {
        const bf16x8 a0 = *(const LAS bf16x8*)(Ks + r32 * 208 + (2 * d0 + hi) * 16);
        const bf16x8 a1 = *(const LAS bf16x8*)(Ks + (32 + r32) * 208 + (2 * d0 + hi) * 16);
        p0 = MFMA32(a0, qr[d0], p0); p1 = MFMA32(a1, qr[d0], p1);
    }
    __builtin_amdgcn_s_setprio(0);
    if (MASK) {
        asm volatile("" ::: "memory");
#pragma unroll
        for (int r = 0; r < 16; ++r) { const int kv = kv0 + crow(r, hi); if (kv > qrow) p0[r] = -INFINITY; if (kv + 32 > qrow) p1[r] = -INFINITY; }
    }
    float mxa = max3f(p0[0], p0[1], p1[0]), mxb = max3f(p0[2], p0[3], p1[1]); mxa = max3f(mxa, p1[2], p1[3]);
#pragma unroll
    for (int r = 4; r < 16; r += 4) { mxa = max3f(mxa, p0[r], p0[r + 1]); mxb = max3f(mxb, p0[r + 2], p0[r + 3]); mxa = max3f(mxa, p1[r], p1[r + 1]); mxb = max3f(mxb, p1[r + 2], p1[r + 3]); }
    float mx = max2f(mxa, mxb);
    mx = max2f(mx, __shfl_xor(mx, 32));
    if (__any(mx > AT_THR)) {
        const float dm = max2f(mx, 0.f);
        const float alpha = __builtin_amdgcn_exp2f(-dm);
        mrun += dm; lrun *= alpha;
#pragma unroll
        for (int r = 0; r < 16; ++r) { o0[r] *= alpha; o1[r] *= alpha; p0[r] -= dm; p1[r] -= dm; negm[r] = -mrun; }
    }
    float ls = 0.f;
#pragma unroll
    for (int r = 0; r < 16; ++r) { p0[r] = __builtin_amdgcn_exp2f(p0[r]); p1[r] = __builtin_amdgcn_exp2f(p1[r]); ls += p0[r] + p1[r]; }
    lrun += ls;
#pragma unroll
    for (int ks = 0; ks < 4; ++ks) {
        u32x4 pp;
        if (ks == 0) { pp.x = pk2(p0[0], p0[1]); pp.y = pk2(p0[2], p0[3]); pp.z = pk2(p0[4], p0[5]); pp.w = pk2(p0[6], p0[7]); }
        else if (ks == 1) { pp.x = pk2(p0[8], p0[9]); pp.y = pk2(p0[10], p0[11]); pp.z = pk2(p0[12], p0[13]); pp.w = pk2(p0[14], p0[15]); }
        else if (ks == 2) { pp.x = pk2(p1[0], p1[1]); pp.y = pk2(p1[2], p1[3]); pp.z = pk2(p1[4], p1[5]); pp.w = pk2(p1[6], p1[7]); }
        else { pp.x = pk2(p1[8], p1[9]); pp.y = pk2(p1[10], p1[11]); pp.z = pk2(p1[12], p1[13]); pp.w = pk2(p1[14], p1[15]); }
        const bf16x8 pa = __builtin_bit_cast(bf16x8, pp);
        const LAS unsigned char* vp = Vs + r32 * 136 + (16 * ks + 4 * hi) * 2;
        const u32x2 l0 = *(const LAS u32x2*)vp, h0 = *(const LAS u32x2*)(vp + 16);
        const u32x2 l1 = *(const LAS u32x2*)(vp + 32 * 136), h1 = *(const LAS u32x2*)(vp + 32 * 136 + 16);
        u32x4 v0 = {l0.x, l0.y, h0.x, h0.y}, v1 = {l1.x, l1.y, h1.x, h1.y};
        o0 = MFMA32(__builtin_bit_cast(bf16x8, v0), pa, o0);
        o1 = MFMA32(__builtin_bit_cast(bf16x8, v1), pa, o1);
    }
}
#ifdef ATTN_DUP
DI void attn_dup_qk(const LAS unsigned char* Ks, const bf16x8 (&qr)[6], const f32x16& negm, int r32, int hi) {
    f32x16 p0, p1;
    { const bf16x8 a0 = *(const LAS bf16x8*)(Ks + r32 * 208 + hi * 16); const bf16x8 a1 = *(const LAS bf16x8*)(Ks + (32 + r32) * 208 + hi * 16); p0 = MFMA32(a0, qr[0], negm); p1 = MFMA32(a1, qr[0], negm); }
#pragma unroll
    for (int d0 = 1; d0 < 6; ++d0) { const bf16x8 a0 = *(const LAS bf16x8*)(Ks + r32 * 208 + (2 * d0 + hi) * 16); const bf16x8 a1 = *(const LAS bf16x8*)(Ks + (32 + r32) * 208 + (2 * d0 + hi) * 16); p0 = MFMA32(a0, qr[d0], p0); p1 = MFMA32(a1, qr[d0], p1); }
    float mxa = max3f(p0[0], p0[1], p1[0]), mxb = max3f(p0[2], p0[3], p1[1]); mxa = max3f(mxa, p1[2], p1[3]);
#pragma unroll
    for (int r = 4; r < 16; r += 4) { mxa = max3f(mxa, p0[r], p0[r + 1]); mxb = max3f(mxb, p0[r + 2], p0[r + 3]); mxa = max3f(mxa, p1[r], p1[r + 1]); mxb = max3f(mxb, p1[r + 2], p1[r + 3]); }
    float mx = max2f(mxa, mxb); mx = max2f(mx, __shfl_xor(mx, 32));
    float ls = mx;
#pragma unroll
    for (int r = 0; r < 16; ++r) { ls += __builtin_amdgcn_exp2f(p0[r]) + __builtin_amdgcn_exp2f(p1[r]); }
    asm volatile("" :: "v"(ls));
}
#define AT_DUP(t) attn_dup_qk(Ks_, qr, negm, r32, hi);
#else
#define AT_DUP(t)
#endif
DI void attn_unit(int b, int h, int qb, const bf16* Qb, const bf16* Kb, const bf16* Vt, const int* positions, bf16* O, LAS unsigned char* lds, int tid) {
    const int wave = __builtin_amdgcn_readfirstlane(tid >> 6), lane = tid & 63, r32 = lane & 31, hi = lane >> 5;
    const int rowbase = b * T, q0 = qb * 256, qrow = q0 + 32 * wave + r32;
    const int kkey0 = tid / 12, kc0 = tid % 12, vd = tid >> 3, vc = tid & 7;
    const bf16* kg0 = Kb + (size_t)(rowbase + kkey0) * 768 + h * 96 + kc0 * 8;
    const bf16* vg = Vt + (size_t)(h * 64 + vd) * VT_LD + rowbase + vc * 8;
    const int NT = (q0 + 256) / 64, NTF = q0 / 64;
    const int kp1 = tid < 256 ? 512 + tid : tid;
    const int kkey1 = kp1 / 12, kc1 = kp1 % 12;
    const bf16* kg1 = Kb + (size_t)(rowbase + kkey1) * 768 + h * 96 + kc1 * 8;
    u32x4 kA0, kA1, vA, kB0, kB1, vB, kC0, kC1, vC;
#define AT_COMMIT(S, stage) do { LAS unsigned char* Ks_ = lds + (stage) * AT_STAGE; LAS unsigned char* Vs_ = Ks_ + AT_KS; \
        *(LAS u32x4*)(Ks_ + kkey0 * 208 + kc0 * 16) = k##S##0; *(LAS u32x4*)(Ks_ + kkey1 * 208 + kc1 * 16) = k##S##1; \
        *(LAS u32x2*)(Vs_ + vd * 136 + vc * 16) = (u32x2){v##S.x, v##S.y}; *(LAS u32x2*)(Vs_ + vd * 136 + vc * 16 + 8) = (u32x2){v##S.z, v##S.w}; } while (0)
#define AT_ISSUE(S, t) do { const int tt_ = (t) < NT ? (t) : NT - 1; const size_t ko_ = (size_t)tt_ * 64 * 768; \
        k##S##0 = *(const u32x4*)(kg0 + ko_); k##S##1 = *(const u32x4*)(kg1 + ko_); v##S = *(const u32x4*)(vg + tt_ * 64); } while (0)
#define AT_TILE(t, stage) do { if ((t) < NT && 64 * (t) <= qmax_w) { const LAS unsigned char* Ks_ = lds + (stage) * AT_STAGE; \
        attn_tile((t) >= NTF, Ks_, Ks_ + AT_KS, qr, negm, mrun, lrun, o0, o1, 64 * (t), qrow, r32, hi); AT_DUP(t) } } while (0)
    AT_ISSUE(A, 0); AT_ISSUE(B, 1); AT_ISSUE(C, 2);
    bf16x8 qr[6];
    {
        const bf16* qp = Qb + (size_t)(rowbase + qrow) * 768 + h * 96 + 8 * hi;
        float qv[6][8];
#pragma unroll
        for (int d0 = 0; d0 < 6; ++d0) { const u32x4 a = *(const u32x4*)(qp + 16 * d0);
            qv[d0][0] = bflo(a.x); qv[d0][1] = bfhi(a.x); qv[d0][2] = bflo(a.y); qv[d0][3] = bfhi(a.y); qv[d0][4] = bflo(a.z); qv[d0][5] = bfhi(a.z); qv[d0][6] = bflo(a.w); qv[d0][7] = bfhi(a.w); }
        const int pos = positions[rowbase + qrow];
#pragma unroll
        for (int i = 0; i < 8; ++i) { float c, s; rope_cs(pos, 8 * hi + i, c, s); const float x1 = qv[4][i], x2 = qv[5][i]; qv[4][i] = x1 * c - x2 * s; qv[5][i] = x1 * s + x2 * c; }
        const float C2 = 0.10206207261596575f * 1.4426950408889634f;
#pragma unroll
        for (int d0 = 0; d0 < 6; ++d0) { u32x4 p; p.x = pk2(qv[d0][0] * C2, qv[d0][1] * C2); p.y = pk2(qv[d0][2] * C2, qv[d0][3] * C2); p.z = pk2(qv[d0][4] * C2, qv[d0][5] * C2); p.w = pk2(qv[d0][6] * C2, qv[d0][7] * C2);
            qr[d0] = __builtin_bit_cast(bf16x8, p); }
    }
    AT_COMMIT(A, 0);
    AT_ISSUE(A, 3);
    float mrun = 0.f, lrun = 0.f;
    f32x16 o0 = {}, o1 = {}, negm = {};
    const int qmax_w = q0 + 32 * wave + 31;
    for (int t = 0; t < NT; t += 3) {
        __syncthreads();
        AT_COMMIT(B, 1); AT_ISSUE(B, t + 4);
        AT_TILE(t, 0);
        __syncthreads();
        AT_COMMIT(C, 2); AT_ISSUE(C, t + 5);
        AT_TILE(t + 1, 1);
        __syncthreads();
        AT_COMMIT(A, 0); AT_ISSUE(A, t + 6);
        AT_TILE(t + 2, 2);
    }
    __syncthreads();
#undef AT_COMMIT
#undef AT_ISSUE
#undef AT_TILE
    lrun += __shfl_xor(lrun, 32);
    const float inv = 1.0f / lrun;
    bf16* op = O + (size_t)(rowbase + qrow) * 1024 + h * 64;
#pragma unroll
    for (int g4 = 0; g4 < 4; ++g4) {
        const int d0 = 8 * g4 + 4 * hi;
        u32x2 w; w.x = pk2(o0[4 * g4] * inv, o0[4 * g4 + 1] * inv); w.y = pk2(o0[4 * g4 + 2] * inv, o0[4 * g4 + 3] * inv); *(u32x2*)(op + d0) = w;
        w.x = pk2(o1[4 * g4] * inv, o1[4 * g4 + 1] * inv); w.y = pk2(o1[4 * g4 + 2] * inv, o1[4 * g4 + 3] * inv); *(u32x2*)(op + 32 + d0) = w;
    }
}


#define XB_TMO      128
#define XB_XCNT(j)  (256  + 64 * (j))
#define XB_XSUB(j)  (1280 + 64 * (j))
#define XB_XGEN(j)  (2304 + 64 * (j))
#define XB_TOP      3328
#define XB_TOPGEN   3392
#define XCD_BAR_WORDS 3456
#define XB_QHEAD(j) (3520 + 64 * (j))
#define BAR_ZERO_WORDS 4096
#define XB_SPIN_CAP (1u << 21)
__device__ __forceinline__ unsigned xb_ld(unsigned* p)              { return __hip_atomic_load(p, __ATOMIC_RELAXED, __HIP_MEMORY_SCOPE_AGENT); }
__device__ __forceinline__ unsigned xb_add(unsigned* p, unsigned v) { return __hip_atomic_fetch_add(p, v, __ATOMIC_RELAXED, __HIP_MEMORY_SCOPE_AGENT); }
__device__ __forceinline__ unsigned xb_xcc_id() { return (unsigned)__builtin_amdgcn_s_getreg((3 << 11) | 20) & 0xFu; }
#define XB_SPIN(cond, bar) do { unsigned _sp = 0; while (cond) { __builtin_amdgcn_s_sleep(1); \
    if ((++_sp & 255u) == 0u) { if (xb_ld(&(bar)[XB_TMO])) break; if (_sp > XB_SPIN_CAP) { atomicAdd(&(bar)[XB_TMO], 1u); break; } } } } while (0)
struct XcdBarrier { unsigned* bar; unsigned x; volatile LAS unsigned* st; };
__device__ __forceinline__ XcdBarrier xcd_barrier_post(unsigned* bar, volatile LAS unsigned* st) {
    XcdBarrier b; b.bar = bar; b.x = xb_xcc_id(); b.st = st;
    if (threadIdx.x == 0) (void)xb_add(&bar[XB_XCNT(b.x)], 1u);
    return b;
}
__device__ __forceinline__ void xcd_barrier_complete(unsigned* bar, unsigned x, unsigned& nloc, unsigned& nx) {
    const unsigned G = gridDim.x * gridDim.y * gridDim.z;
    unsigned sum, cnt, mine, sp = 0u;
    for (;;) {
        sum = 0u; cnt = 0u; mine = 0u;
#pragma unroll
        for (unsigned j = 0; j < 16; ++j) { const unsigned c = xb_ld(&bar[XB_XCNT(j)]); sum += c; cnt += (c > 0u) ? 1u : 0u; mine = (j == x) ? c : mine; }
        if (sum == G) break;
        __builtin_amdgcn_s_sleep(1);
        if ((++sp & 255u) == 0u) { if (xb_ld(&bar[XB_TMO])) break; if (sp > XB_SPIN_CAP) { atomicAdd(&bar[XB_TMO], 1u); break; } }
    }
    nloc = mine > 0u ? mine : 1u; nx = cnt > 0u ? cnt : 1u;
}
__device__ __forceinline__ void xcd_barrier(const XcdBarrier& b) {
    asm volatile("s_waitcnt vmcnt(0)" ::: "memory");
    __syncthreads();
    if (threadIdx.x == 0) {
        unsigned* bar = b.bar;
        __builtin_amdgcn_s_waitcnt(0);
        unsigned nloc = b.st[0], nx = b.st[1];
        if (nloc == 0u) { xcd_barrier_complete(bar, b.x, nloc, nx); b.st[0] = nloc; b.st[1] = nx; }
        const unsigned old = xb_add(&bar[XB_XSUB(b.x)], 1u);
        const unsigned gen = old / nloc;
        if (old + 1u == (gen + 1u) * nloc) {
            __builtin_amdgcn_fence(__ATOMIC_RELEASE, "agent");
            asm volatile("s_waitcnt vmcnt(0)" ::: "memory");
            const unsigned og = xb_add(&bar[XB_TOP], 1u);
            const unsigned tg = og / nx;
            if (og + 1u == (tg + 1u) * nx) xb_add(&bar[XB_TOPGEN], 1u);
            else XB_SPIN(xb_ld(&bar[XB_TOPGEN]) == tg, bar);
            __builtin_amdgcn_fence(__ATOMIC_ACQUIRE, "agent");
            xb_add(&bar[XB_XGEN(b.x)], 1u);
            asm volatile("s_waitcnt vmcnt(0)" ::: "memory");
        } else {
            XB_SPIN(xb_ld(&bar[XB_XGEN(b.x)]) == gen, bar);
            __builtin_amdgcn_fence(__ATOMIC_ACQUIRE, "agent");
            asm volatile("s_waitcnt vmcnt(0)" ::: "memory");
        }
    }
    __syncthreads();
}
#ifndef MK_PER_PHASE
#define MK_PER_PHASE 0
#endif
__global__ void __launch_bounds__(512, 2) mk_fwd(Args a) {
    extern __shared__ __attribute__((aligned(16))) unsigned char lds_raw[];
    LAS unsigned char* lds = (LAS unsigned char*)lds_raw;
    cg::grid_group grid = cg::this_grid();
    const int tid = threadIdx.x, lane = tid & 63, wave = __builtin_amdgcn_readfirstlane(tid >> 6);
    const int G = gridDim.x, bid = blockIdx.x, gw = bid * 8 + wave, NGW = G * 8;
    const int lo = a.ph_lo, hi = a.ph_hi;
#ifndef PHMASK
#define PHMASK 0xffff
#endif
#define IN(k) (((PHMASK >> (k)) & 1) && lo <= (k) && (k) < hi)
#define SEAM(k) do { if (IN(k) && IN((k) + 1)) xcd_barrier(xbar); } while (0)
#ifndef PHREP
#define PHREP 0
#endif
#ifndef XSYNC
#define XSYNC 0
#endif
#define PH(k) if (IN(k)) for (int rep_ = 0; rep_ < (((PHREP >> (k)) & 1) ? 2 : 1); ++rep_)
    unsigned char* ws = a.ws;
    unsigned* barw = (unsigned*)(ws + WS_BAR);
    volatile LAS unsigned* st = (volatile LAS unsigned*)(lds + LDS_BYTES - 16);
    LAS int* qslot = (LAS int*)(lds + LDS_BYTES - 32);
    if (tid < 4) st[tid] = 0u;
    __syncthreads();
    XcdBarrier xbar; xbar.bar = barw; xbar.x = 0; xbar.st = st;
    if (hi - lo > 1) xbar = xcd_barrier_post(barw, st);
    if (lo < 0) grid.sync();
    const float* x = (const float*)a.in[0]; const int* positions = (const int*)a.in[1];
    bf16* W1GU = (bf16*)(ws + WS_W1GU); bf16* W1D = (bf16*)(ws + WS_W1D); bf16* WIN = (bf16*)(ws + WS_WIN); bf16* WUQ = (bf16*)(ws + WS_WUQ); bf16* WKV = (bf16*)(ws + WS_WKV);
    bf16* WOUT = (bf16*)(ws + WS_WOUT); bf16* W2GU = (bf16*)(ws + WS_W2GU); bf16* W2D = (bf16*)(ws + WS_W2D);
    float* ROWSQ = (float*)(ws + WS_ROWSQ); float* GLAST = (float*)(ws + WS_GLAST); float* RS2 = (float*)(ws + WS_RS); float* RS3 = RS2 + M;
    bf16* P = (bf16*)(ws + WS_P); bf16* Q = (bf16*)(ws + WS_Q); bf16* H = (bf16*)(ws + WS_H); unsigned char* GB = ws + WS_G;
    bf16* CQN = (bf16*)(ws + WS_P + P_CQN); bf16* CKVN = (bf16*)(ws + WS_P + P_CKVN); bf16* MLAO = (bf16*)(ws + WS_P + P_MLAO);
    bf16* PS = (bf16*)(ws + WS_H + H_PS); bf16* QKV = (bf16*)(ws + WS_H + H_QKV); bf16* KB = (bf16*)(ws + WS_H + H_KB); bf16* VT = (bf16*)(ws + WS_H + H_VT); bf16* OG = (bf16*)(ws + WS_H + H_OG);
    LAS unsigned char* wl = lds + wave * WAVE_LDS;

    PH(0) {
        LAS float* scr = (LAS float*)wl;
        constexpr int I_GU = 16 * 88, I_D = 44 * 32, I_IN = 16 * 78, I_UQ = 4 * 24, I_KV = 2 * 32, I_OUT = 16 * 32;
        constexpr int NITEMS = 2 * (2 * I_GU + I_D) + I_IN + I_UQ + I_KV + I_OUT;
        for (int it = gw; it < NITEMS; it += NGW) {
            int r = it;
            if (r < I_GU) { transpose_item((const float*)a.in[3], 1024, 2816, W1GU, 1, scr, r, lane); continue; } r -= I_GU;
            if (r < I_GU) { transpose_item((const float*)a.in[4], 1024, 2816, W1GU, 2, scr, r, lane); continue; } r -= I_GU;
            if (r < I_D) { transpose_item((const float*)a.in[5], 2816, 1024, W1D, 0, scr, r, lane); continue; } r -= I_D;
            if (r < I_GU) { transpose_item((const float*)a.in[21], 1024, 2816, W2GU, 1, scr, r, lane, (const float*)a.in[20]); continue; } r -= I_GU;
            if (r < I_GU) { transpose_item((const float*)a.in[22], 1024, 2816, W2GU, 2, scr, r, lane, (const float*)a.in[20]); continue; } r -= I_GU;
            if (r < I_D) { transpose_item((const float*)a.in[23], 2816, 1024, W2D, 0, scr, r, lane); continue; } r -= I_D;
            if (r < I_IN) { transpose_item((const float*)a.in[8], 1024, 2480, WIN, 3, scr, r, lane, (const float*)a.in[7]); continue; } r -= I_IN;
            if (r < I_UQ) { transpose_item((const float*)a.in[10], 256, 768, WUQ, 0, scr, r, lane); continue; } r -= I_UQ;
            if (r < I_KV) { transpose_item((const float*)a.in[12], 128, 1024, WKV, 4, scr, r, lane); continue; } r -= I_KV;
            transpose_item((const float*)a.in[18], 1024, 1024, WOUT, 0, scr, r, lane);
        }
        for (int i = bid * 512 + tid; i < 80 * 1024 / 8; i += G * 512) *(u32x4*)(WIN + 944 * 1024 + (size_t)i * 8) = (u32x4){0u, 0u, 0u, 0u};
        for (int m = gw; m < M; m += 4 * NGW) rms_rows_to_bf16<4>(x, (const float*)a.in[2], P, m, NGW, lane);
    }
    SEAM(0);
    for (int xs_ = 0; xs_ < XSYNC; ++xs_) grid.sync();
    PH(1) {
        pg8::Gemm g{P, W1GU, M, 5632, 1024}; pg8::StaticOrder S; S.init(M, 5632, G, bid);
        pg8::EpiSwiGLU E{H, FF, nullptr};
        pg8::gemm_phase<pg8::EpiSwiGLU, pg8::StaticOrder, true, true>(lds, g, S, E);
    }
    SEAM(1);
    PH(2) {
        pg8::Gemm g{H, W1D, M, 1024, 2816}; pg8::StaticOrder S; S.init(M, 1024, G, bid);
        pg8::EpiBf16Sq E{Q, ROWSQ};
        pg8::gemm_phase<pg8::EpiBf16Sq, pg8::StaticOrder, true, true>(lds, g, S, E);
    }
    SEAM(2);
    PH(3) {
        for (int m = gw; m < M; m += 4 * NGW) resid_rows<4, false, true>(x, a.out, Q, ROWSQ, 0.5f, (const float*)a.in[6], nullptr, nullptr, m, NGW, lane, RS2);
    }
    SEAM(3);
    PH(4) {
        pg8::Gemm g{(const bf16*)a.out, WIN, M, 2560, 1024}; pg8::StaticOrder S; S.init(M, 2560, G, bid);
        pg8::EpiStore<1> E{PS, 1024, QKV, RS2};
        pg8::gemm_phase<pg8::EpiStore<1>, pg8::StaticOrder, true, true>(lds, g, S, E);
    }
    SEAM(4);
    PH(5) {
        for (int m = gw; m < M; m += 4 * NGW) e2_rows<4>(PS, (const float*)a.in[9], (const float*)a.in[11], CQN, CKVN, m, NGW, lane);
        for (int uid = gw; uid < 4096; uid += NGW)
            gdn_prep_unit(uid, QKV, PS, (const float*)a.in[14], (const float*)a.in[15], (const float*)a.in[16], GB, GLAST, wl, lane);
    }
    SEAM(5);
    PH(6) {
#ifndef P6SEL
#define P6SEL 15
#endif
        if (P6SEL & 1) for (int m = gw; m < M; m += 4 * NGW) kpe_rows<4>(PS, positions, KB, m, NGW, lane);
        if (P6SEL & 2) { int kq = 256; asm volatile("" : "+s"(kq)); pg8::Gemm g{CQN, WUQ, M, 768, kq}; pg8::StaticOrder S; S.init(M, 768, G, bid); pg8::EpiStore<0> E{Q, 768, nullptr, nullptr};
          pg8::gemm_phase<pg8::EpiStore<0>, pg8::StaticOrder, false, true>(lds, g, S, E); }
        if (P6SEL & 4) { int kq = 128; asm volatile("" : "+s"(kq)); pg8::Gemm g{CKVN, WKV, M, 512, kq}; pg8::StaticOrder S; S.init(M, 512, G, bid); pg8::EpiStore<2> E{KB, 768, nullptr, nullptr};
          pg8::gemm_phase<pg8::EpiStore<2>, pg8::StaticOrder, false, true>(lds, g, S, E); }
        if ((P6SEL & 8) && (G != 256 || bid >= 128)) { int kq = 128; asm volatile("" : "+s"(kq)); pg8::Gemm g{WKV + 512 * 128, CKVN, 512, M, kq}; pg8::StaticOrder S;
          if (G == 256) S.init(512, M, 128, bid - 128); else S.init(512, M, G, bid);     pg8::EpiStore<0> E{VT, VT_LD, nullptr, nullptr};
          pg8::gemm_phase<pg8::EpiStore<0>, pg8::StaticOrder, false, true>(lds, g, S, E); }
    }
    SEAM(6);
    PH(7) {
#ifndef SCANREP
#define SCANREP 1
#endif
        for (int sr_ = 0; sr_ < SCANREP; ++sr_) for (int s = bid; s < 64; s += G) gdn_scan(s >> 3, s & 7, GB, GLAST, PS, (const float*)a.in[17], P, lds, tid);
        const int NQ = G >= 8 ? 8 : 1, xq = bid % NQ, per_q = 1024 / NQ;
#ifndef ATTNREP
#define ATTNREP 1
#endif
        int ticket = 0;
        if (tid == 0) ticket = (int)xb_add(&barw[XB_QHEAD(xq)], 1u);
        if (tid == 0) *qslot = ticket;
        __syncthreads();
        int q = *qslot;
        __syncthreads();
        while (q < per_q) {
            if (tid == 0) ticket = (int)xb_add(&barw[XB_QHEAD(xq)], 1u);
            const int bh = NQ == 8 ? xq * 8 + (q & 7) : (q & 63), qb = NQ == 8 ? 15 - (q >> 3) : 15 - (q >> 6);
            for (int ar_ = 0; ar_ < ATTNREP; ++ar_) attn_unit(bh >> 3, bh & 7, qb, Q, KB, VT, positions, P, lds, tid);
            if (tid == 0) *qslot = ticket;
            __syncthreads();
            q = *qslot;
            __syncthreads();
        }
    }
    SEAM(7);
    PH(8) {
        for (int m = gw; m < M; m += 4 * NGW) mla_norm_rows<4>(P, (const float*)a.in[13], m, NGW, lane);
    }
    SEAM(8);
    PH(9) {
        pg8::Gemm g{P, WOUT, M, 1024, 1024}; pg8::StaticOrder S; S.init(M, 1024, G, bid);
        pg8::EpiBf16Sq E{Q, ROWSQ};
        pg8::gemm_phase<pg8::EpiBf16Sq, pg8::StaticOrder, true, true>(lds, g, S, E);
    }
    SEAM(9);
    PH(10) {
        for (int m = gw; m < M; m += 4 * NGW) resid_rows<4, true, true>(a.out, GB, Q, ROWSQ, 1.0f, (const float*)a.in[19], nullptr, nullptr, m, NGW, lane, RS3);
    }
    SEAM(10);
    PH(11) {
        pg8::Gemm g{(const bf16*)GB, W2GU, M, 5632, 1024}; pg8::StaticOrder S; S.init(M, 5632, G, bid);
        pg8::EpiSwiGLU E{H, FF, RS3};
        pg8::gemm_phase<pg8::EpiSwiGLU, pg8::StaticOrder, true, true>(lds, g, S, E);
    }
    SEAM(11);
    PH(12) {
        pg8::Gemm g{H, W2D, M, 1024, 2816}; pg8::StaticOrder S; S.init(M, 1024, G, bid);
        pg8::EpiBf16Sq E{Q, ROWSQ};
        pg8::gemm_phase<pg8::EpiBf16Sq, pg8::StaticOrder, true, true>(lds, g, S, E);
    }
    SEAM(12);
    PH(13) {
        for (int m = gw; m < M; m += 4 * NGW) resid_rows<4, true, false>(GB, a.out, Q, ROWSQ, 0.5f, (const float*)a.in[24], nullptr, nullptr, m, NGW, lane);
    }
#undef IN
#undef SEAM
}

extern "C" void kernel_launch(void* const* d_in, const int* in_sizes, int n_in, void* d_out, int out_size, void* d_ws, size_t ws_size, hipStream_t stream) {
    static int grid = 0;
    if (grid == 0) {
        if (n_in != 25 || out_size != M * DM || ws_size < WS_END) { fprintf(stderr, "kernel_launch: unexpected problem shape / workspace (n_in %d out %d ws %zu need %zu)\n", n_in, out_size, ws_size, (size_t)WS_END); grid = -1; return; }
        int dev = 0, cus = 0, per_cu = 0;
        if (hipGetDevice(&dev) != hipSuccess || hipDeviceGetAttribute(&cus, hipDeviceAttributeMultiprocessorCount, dev) != hipSuccess) { grid = -1; return; }
        if (hipFuncSetAttribute((const void*)mk_fwd, hipFuncAttributeMaxDynamicSharedMemorySize, LDS_BYTES) != hipSuccess) { fprintf(stderr, "kernel_launch: hipFuncSetAttribute failed\n"); grid = -1; return; }
        if (hipOccupancyMaxActiveBlocksPerMultiprocessor(&per_cu, (const void*)mk_fwd, 512, LDS_BYTES) != hipSuccess || per_cu < 1) { fprintf(stderr, "kernel_launch: occupancy query says %d blocks per CU\n", per_cu); (void)hipGetLastError(); per_cu = 1; }
        grid = cus * 1;
    }
    if (grid < 0) return;
    Args a{};
    for (int i = 0; i < 25; ++i) a.in[i] = d_in[i];
    a.out = (float*)d_out; a.ws = (unsigned char*)d_ws;
#if MK_PER_PHASE
    for (int p = 0; p < NPH; ++p) { a.ph_lo = p; a.ph_hi = p + 1; hipLaunchKernelGGL(mk_fwd, dim3(grid), dim3(512), LDS_BYTES, stream, a); }
#else
    a.ph_lo = 0; a.ph_hi = NPH;
    if (hipMemsetAsync((unsigned char*)d_ws + WS_BAR, 0, BAR_ZERO_WORDS * 4, stream) != hipSuccess) { fprintf(stderr, "kernel_launch: memset of the barrier words failed\n"); return; }
    void* args[] = {&a};
    hipError_t e = hipLaunchCooperativeKernel((const void*)mk_fwd, dim3(grid), dim3(512), args, LDS_BYTES, stream);
    if (e != hipSuccess) fprintf(stderr, "kernel_launch: cooperative launch failed: %s (grid %d)\n", hipGetErrorString(e), grid);
#endif
}
```

```cpp
#include <hip/hip_runtime.h>
#include <hip/hip_cooperative_groups.h>
#include <cstdio>
#include <cstdint>
#include <cmath>
namespace cg = cooperative_groups;
namespace pg8 {
#define PG8_LAS __attribute__((address_space(3)))
typedef unsigned short bf16_t;
typedef short bf16x8 __attribute__((ext_vector_type(8)));
typedef float f32x4 __attribute__((ext_vector_type(4)));
typedef unsigned u32x4 __attribute__((ext_vector_type(4)));
constexpr int BM = 256, BK = 64, HALF = 128, HTB = HALF * BK * 2  , STAGE_BYTES = 8 * HTB, NXCD = 8, WGM = 8;

__host__ __device__ __forceinline__ int lds_byte(int r, int c) { const int st = (r >> 4) * 2 + (c >> 5), rr = r & 15, cc = c & 31, ob = rr * 64 + cc * 2; return st * 1024 + (ob ^ (((ob >> 9) & 1) << 5)); }
__host__ __device__ __forceinline__ void stage_rc(int b, int& R, int& C) { const int st = b / 1024, sb = b % 1024, swz = sb ^ (((sb >> 9) & 1) << 5); R = (st >> 1) * 16 + swz / 64; C = (st & 1) * 32 + (swz % 64) / 2; }
__host__ __device__ __forceinline__ int perm32(int rho) { const int n = rho >> 4, i = rho & 15; return 8 * (i >> 2) + 4 * n + (i & 3); }

struct Unit { int pm, pn; };
struct Gemm { const bf16_t* A; const bf16_t* Bt; int M, N, K; };

struct StaticOrder {
    int nM, nN, nwg, G, c;
    __host__ __device__ void init(int M, int N, int G_, int c_) { nM = M / BM; nN = N / BM; nwg = nM * nN; G = G_; c = c_; }
    __host__ __device__ bool next(int i, Unit& u) const {
        const long L = (long)i * G + c; if (L >= nwg) return false;
        int wgid = (int)L; { const int q = nwg / NXCD, r = nwg % NXCD, xcd = wgid % NXCD, off = wgid / NXCD; wgid = (xcd < r ? xcd * (q + 1) : r * (q + 1) + (xcd - r) * q) + off; }
        const int nig = WGM * nN, gid = wgid / nig, fm = gid * WGM, gsz = (nM - fm) < WGM ? (nM - fm) : WGM;
        u.pm = fm + ((wgid % nig) % gsz); u.pn = (wgid % nig) / gsz; return true;
    }
    __device__ __forceinline__ void a_ready(const Unit&) const {}
    __device__ __forceinline__ void done(const Unit&) const {}
};

__device__ __forceinline__ unsigned cvt_pk_bf16(float lo, float hi) { unsigned r; asm volatile("v_cvt_pk_bf16_f32 %0, %1, %2" : "=v"(r) : "v"(lo), "v"(hi)); return r; }
struct EpiSwiGLU {
    static constexpr bool PERM = true, AFTER_DRAIN = false;
    bf16_t* O; int ldc; const float* rs;
    __device__ __forceinline__ void operator()(const f32x4 (&acc)[2][2][4][2], const Unit& u, int wr, int wc, int fr, int fq) const {
        const int row0 = u.pm * BM + wr * 64 + fr, col0 = u.pn * 128 + wc * 32 + 8 * fq;
#pragma unroll
        for (int ai = 0; ai < 2; ++ai)
#pragma unroll
            for (int m = 0; m < 4; ++m) {
                bf16_t* p = O + (size_t)(row0 + ai * HALF + m * 16) * ldc + col0;
                float h[8]; const float rsc = rs ? rs[row0 + ai * HALF + m * 16] : 1.0f;
#pragma unroll
                for (int n = 0; n < 2; ++n)
#pragma unroll
                    for (int i = 0; i < 4; ++i) { const float g = acc[ai][0][m][n][i] * rsc, uu = acc[ai][1][m][n][i] * rsc; h[4 * n + i] = g * __builtin_amdgcn_rcpf(1.0f + __builtin_amdgcn_exp2f(g)) * uu; }
                u32x4 w; w.x = cvt_pk_bf16(h[0], h[1]); w.y = cvt_pk_bf16(h[2], h[3]); w.z = cvt_pk_bf16(h[4], h[5]); w.w = cvt_pk_bf16(h[6], h[7]);
                *(u32x4*)p = w;
            }
    }
};
struct EpiBf16Sq {
    static constexpr bool PERM = true, AFTER_DRAIN = false;
    bf16_t* O; float* rsq;
    __device__ __forceinline__ void operator()(const f32x4 (&acc)[2][2][4][2], const Unit& u, int wr, int wc, int fr, int fq) const {
        const int row0 = u.pm * BM + wr * 64 + fr, col0 = u.pn * BM + wc * 32 + 8 * fq;
#pragma unroll
        for (int ai = 0; ai < 2; ++ai)
#pragma unroll
            for (int m = 0; m < 4; ++m) {
                const int row = row0 + ai * HALF + m * 16; float s = 0.f;
#pragma unroll
                for (int bj = 0; bj < 2; ++bj) {
                    const f32x4 v0 = acc[ai][bj][m][0], v1 = acc[ai][bj][m][1];
                    s += (v0[0] * v0[0] + v0[1] * v0[1]) + (v0[2] * v0[2] + v0[3] * v0[3]) + (v1[0] * v1[0] + v1[1] * v1[1]) + (v1[2] * v1[2] + v1[3] * v1[3]);
                    u32x4 w; w.x = cvt_pk_bf16(v0[0], v0[1]); w.y = cvt_pk_bf16(v0[2], v0[3]); w.z = cvt_pk_bf16(v1[0], v1[1]); w.w = cvt_pk_bf16(v1[2], v1[3]);
                    *(u32x4*)(O + (size_t)row * 1024 + col0 + bj * HALF) = w;
                }
                s += __shfl_xor(s, 16); s += __shfl_xor(s, 32);
                if (fq == 0) rsq[(size_t)row * 16 + u.pn * 4 + wc] = s;
            }
    }
};
template <int MODE> struct EpiStore {
    static constexpr bool PERM = true, AFTER_DRAIN = false;
    bf16_t* O; int ldc; bf16_t* O2; const float* rs;
    __device__ __forceinline__ void operator()(const f32x4 (&acc)[2][2][4][2], const Unit& u, int wr, int wc, int fr, int fq) const {
        const int row0 = u.pm * BM + wr * 64 + fr;
#pragma unroll
        for (int bj = 0; bj < 2; ++bj) {
            const int c = u.pn * BM + bj * HALF + wc * 32 + 8 * fq;
            bf16_t* base; size_t ld;
            if (MODE == 1) { if (c < 1024) { base = O + c; ld = 1024; } else { base = O2 + (c - 1024); ld = 1536; } }
            else if (MODE == 2) { base = O + (c >> 6) * 96 + (c & 63); ld = (size_t)ldc; }
            else { base = O + c; ld = (size_t)ldc; }
#pragma unroll
            for (int ai = 0; ai < 2; ++ai)
#pragma unroll
                for (int m = 0; m < 4; ++m) {
                    const float rsc = rs ? rs[row0 + ai * HALF + m * 16] : 1.0f;
                    const f32x4 v0 = acc[ai][bj][m][0] * rsc, v1 = acc[ai][bj][m][1] * rsc;
                    u32x4 w; w.x = cvt_pk_bf16(v0[0], v0[1]); w.y = cvt_pk_bf16(v0[2], v0[3]); w.z = cvt_pk_bf16(v1[0], v1[1]); w.w = cvt_pk_bf16(v1[2], v1[3]);
                    *(u32x4*)(base + (size_t)(row0 + ai * HALF + m * 16) * ld) = w;
                }
        }
    }
};
template <class Epi, class Sched, bool ALIGN_EPI = false, bool SP2 = false>
__device__ __forceinline__ void gemm_phase(PG8_LAS unsigned char* lds, const Gemm g, const Sched& S, const Epi& E) {
    const int tid = threadIdx.x, wid = __builtin_amdgcn_readfirstlane(tid >> 6), lane = tid & 63, wr = wid >> 2, wc = wid & 3, fr = lane & 15, fq = lane >> 4;
    const int K = g.K, nt = K / BK;
    unsigned voffA[2], voffB[2];
#pragma unroll
    for (int i = 0; i < 2; ++i) { int R, C; stage_rc(tid * 16 + i * 8192, R, C); const int Rb = Epi::PERM ? ((R & ~31) + perm32(R & 31)) : R;
        voffA[i] = (unsigned)(R * K + C) * 2u; voffB[i] = (unsigned)(Rb * K + C) * 2u; }
    const size_t kstep = (size_t)(BK * 2);
    const size_t hstep = (size_t)HALF * K * 2;
    const size_t tstep = 2 * hstep;
    const unsigned ldsw = (unsigned)wid * 1024u;
    const int aoff = lds_byte(wr * 64 + fr, fq * 8), boff = lds_byte(wc * 32 + fr, fq * 8);
#define PG8_SA(b, h) (((b) * 2 + (h)) * HTB)
#define PG8_SB(b, h) ((4 + (b) * 2 + (h)) * HTB)
#define PG8_STAGE(bufoff, gbase, voff) do { _Pragma("unroll") for (int _i = 0; _i < 2; ++_i) \
        __builtin_amdgcn_global_load_lds((const unsigned*)((const char*)(gbase) + (voff)[_i]), (PG8_LAS unsigned*)(lds + (bufoff) + ldsw + _i * 8192), 16, 0, 0); } while (0)
#define PG8_LDA(dst, b, h) do { _Pragma("unroll") for (int m = 0; m < 4; ++m) _Pragma("unroll") for (int k = 0; k < 2; ++k) dst[m][k] = *(const PG8_LAS bf16x8*)(lds + PG8_SA(b, h) + aoff + m * 2048 + k * 1024); } while (0)
#define PG8_LDB(dst, b, h) do { _Pragma("unroll") for (int n = 0; n < 2; ++n) _Pragma("unroll") for (int k = 0; k < 2; ++k) dst[n][k] = *(const PG8_LAS bf16x8*)(lds + PG8_SB(b, h) + boff + n * 2048 + k * 1024); } while (0)
#define PG8_MMA(ai, bj, At, Bt) do { __builtin_amdgcn_s_setprio(1); _Pragma("unroll") for (int m = 0; m < 4; ++m) _Pragma("unroll") for (int n = 0; n < 2; ++n) _Pragma("unroll") for (int k = 0; k < 2; ++k) \
        acc[ai][bj][m][n] = __builtin_amdgcn_mfma_f32_16x16x32_bf16(Bt[n][k], At[m][k], acc[ai][bj][m][n], 0, 0, 0); __builtin_amdgcn_s_setprio(0); } while (0)
#define PG8_WAIT_V(n) asm volatile("s_waitcnt vmcnt(" #n ")" ::: "memory")
#define PG8_WAIT_L(n) asm volatile("s_waitcnt lgkmcnt(" #n ")" ::: "memory")
#define PG8_BAR __builtin_amdgcn_s_barrier()
#define PG8_SCHED __builtin_amdgcn_sched_barrier(0)
    Unit cur, nxt; int ui = 0;
    if (!S.next(0, cur)) return;
    f32x4 acc[2][2][4][2];
#pragma unroll
    for (int a = 0; a < 2; ++a)
#pragma unroll
        for (int b = 0; b < 2; ++b)
#pragma unroll
            for (int m = 0; m < 4; ++m)
#pragma unroll
                for (int n = 0; n < 2; ++n) acc[a][b][m][n] = (f32x4){0.f, 0.f, 0.f, 0.f};
    bf16x8 At[4][2], B0[2][2], B1[2][2];
    const char* cA = (const char*)g.A + (size_t)cur.pm * tstep; const char* cB = (const char*)g.Bt + (size_t)cur.pn * tstep;
    S.a_ready(cur);
    if constexpr (SP2) {
        PG8_STAGE(PG8_SB(0, 0), cB, voffB); PG8_STAGE(PG8_SB(0, 1), cB + hstep, voffB); PG8_STAGE(PG8_SA(0, 0), cA, voffA); PG8_STAGE(PG8_SA(0, 1), cA + hstep, voffA);
        if (wr == 1) PG8_BAR;
        PG8_WAIT_V(2); PG8_BAR;
        PG8_STAGE(PG8_SB(1, 0), cB + kstep, voffB); PG8_STAGE(PG8_SA(1, 0), cA + kstep, voffA); PG8_STAGE(PG8_SB(1, 1), cB + hstep + kstep, voffB);
        PG8_WAIT_V(6); PG8_BAR;
    } else {
        PG8_STAGE(PG8_SB(0, 0), cB, voffB); PG8_STAGE(PG8_SA(0, 0), cA, voffA); PG8_STAGE(PG8_SB(0, 1), cB + hstep, voffB); PG8_STAGE(PG8_SA(0, 1), cA + hstep, voffA);
        if (wr == 1) PG8_BAR;
        PG8_WAIT_V(4); PG8_BAR;
        PG8_STAGE(PG8_SB(1, 0), cB + kstep, voffB); PG8_STAGE(PG8_SA(1, 0), cA + kstep, voffA); PG8_STAGE(PG8_SB(1, 1), cB + hstep + kstep, voffB);
        PG8_WAIT_V(6); PG8_BAR;
    }
    for (;;) {
        const bool has_next = S.next(ui + 1, nxt);
        const char* nA = has_next ? (const char*)g.A + (size_t)nxt.pm * tstep : cA; const char* nB = has_next ? (const char*)g.Bt + (size_t)nxt.pn * tstep : cB;
        for (int t = 0; t < nt; t += 2) {
            const bool last = (t == nt - 2);
            const char* a1 = cA + (size_t)(t + 1) * kstep;
            const char* a2 = last ? nA : cA + (size_t)(t + 2) * kstep; const char* b2 = last ? nB : cB + (size_t)(t + 2) * kstep;
            const char* a3 = a2 + kstep; const char* b3 = b2 + kstep;
            if (last && has_next) S.a_ready(nxt);
            if constexpr (SP2) {
            PG8_LDB(B0, 0, 0); PG8_LDB(B1, 0, 1); PG8_SCHED; PG8_LDA(At, 0, 0); PG8_STAGE(PG8_SA(1, 1), a1 + hstep, voffA);
            PG8_WAIT_V(8); PG8_WAIT_L(0); PG8_BAR; PG8_MMA(0, 0, At, B0); PG8_MMA(0, 1, At, B1); PG8_BAR; PG8_SCHED;
            PG8_LDA(At, 0, 1); PG8_STAGE(PG8_SB(0, 0), b2, voffB); PG8_STAGE(PG8_SB(0, 1), b2 + hstep, voffB); PG8_STAGE(PG8_SA(0, 0), a2, voffA);
            PG8_WAIT_V(8); PG8_WAIT_L(0); PG8_BAR; PG8_MMA(1, 0, At, B0); PG8_MMA(1, 1, At, B1); PG8_BAR; PG8_SCHED;
            PG8_LDB(B0, 1, 0); PG8_LDB(B1, 1, 1); PG8_SCHED; PG8_LDA(At, 1, 0); PG8_STAGE(PG8_SA(0, 1), a2 + hstep, voffA);
            PG8_WAIT_V(8); PG8_WAIT_L(0); PG8_BAR; PG8_MMA(0, 0, At, B0); PG8_MMA(0, 1, At, B1); PG8_BAR; PG8_SCHED;
            PG8_LDA(At, 1, 1); PG8_STAGE(PG8_SB(1, 0), b3, voffB); PG8_STAGE(PG8_SB(1, 1), b3 + hstep, voffB); PG8_STAGE(PG8_SA(1, 0), a3, voffA);
            PG8_WAIT_V(8); PG8_WAIT_L(0); PG8_BAR; PG8_MMA(1, 0, At, B0); PG8_MMA(1, 1, At, B1); PG8_BAR; PG8_SCHED;
            } else {
            PG8_LDB(B0, 0, 0); PG8_SCHED; PG8_LDA(At, 0, 0); PG8_STAGE(PG8_SA(1, 1), a1 + hstep, voffA);
            PG8_WAIT_L(8); PG8_BAR; PG8_WAIT_L(0); PG8_MMA(0, 0, At, B0); PG8_BAR; PG8_SCHED;
            PG8_LDB(B1, 0, 1); PG8_STAGE(PG8_SB(0, 0), b2, voffB);
            PG8_BAR; PG8_WAIT_L(0); PG8_MMA(0, 1, At, B1); PG8_BAR;
            PG8_LDA(At, 0, 1); PG8_STAGE(PG8_SA(0, 0), a2, voffA);
            PG8_BAR; PG8_WAIT_L(0); PG8_MMA(1, 0, At, B0); PG8_BAR; PG8_SCHED;
            PG8_STAGE(PG8_SB(0, 1), b2 + hstep, voffB);
            PG8_WAIT_V(6); PG8_BAR; PG8_MMA(1, 1, At, B1); PG8_BAR;
            PG8_LDB(B0, 1, 0); PG8_SCHED; PG8_LDA(At, 1, 0); PG8_STAGE(PG8_SA(0, 1), a2 + hstep, voffA);
            PG8_WAIT_L(8); PG8_BAR; PG8_WAIT_L(0); PG8_MMA(0, 0, At, B0); PG8_BAR; PG8_SCHED;
            PG8_LDB(B1, 1, 1); PG8_STAGE(PG8_SB(1, 0), b3, voffB);
            PG8_BAR; PG8_WAIT_L(0); PG8_MMA(0, 1, At, B1); PG8_BAR;
            PG8_LDA(At, 1, 1); PG8_STAGE(PG8_SA(1, 0), a3, voffA);
            PG8_BAR; PG8_WAIT_L(0); PG8_MMA(1, 0, At, B0); PG8_BAR; PG8_SCHED;
            PG8_STAGE(PG8_SB(1, 1), b3 + hstep, voffB);
            PG8_WAIT_V(6); PG8_BAR; PG8_MMA(1, 1, At, B1); PG8_BAR;
            }
        }
        if constexpr (ALIGN_EPI) { if (wr == 0) PG8_BAR; }
        if constexpr (!Epi::AFTER_DRAIN) { E(acc, cur, wr, wc, fr, fq); S.done(cur); }
        if (!has_next) break;
#pragma unroll
        for (int a = 0; a < 2; ++a)
#pragma unroll
            for (int b = 0; b < 2; ++b)
#pragma unroll
                for (int m = 0; m < 4; ++m)
#pragma unroll
                    for (int n = 0; n < 2; ++n) acc[a][b][m][n] = (f32x4){0.f, 0.f, 0.f, 0.f};
        cur = nxt; cA = nA; cB = nB; ++ui;
        if constexpr (ALIGN_EPI) { if (wr == 1) PG8_BAR; }
    }
    PG8_WAIT_V(0);
    if constexpr (!ALIGN_EPI) { if (wr == 0) PG8_BAR; }
    PG8_BAR;
    if constexpr (Epi::AFTER_DRAIN) { E.fused(acc, cur, wr, wc, fr, fq, lds, wid, lane); S.done(cur); }
#undef PG8_SA
#undef PG8_SB
#undef PG8_STAGE
#undef PG8_LDA
#undef PG8_LDB
#undef PG8_MMA
#undef PG8_WAIT_V
#undef PG8_WAIT_L
#undef PG8_BAR
#undef PG8_SCHED
}
}
#define DI __device__ __forceinline__
#define LAS __attribute__((address_space(3)))
typedef unsigned short bf16;
typedef unsigned u32x4 __attribute__((ext_vector_type(4)));
typedef unsigned u32x2 __attribute__((ext_vector_type(2)));
typedef float f32x4 __attribute__((ext_vector_type(4)));
typedef float f32x16 __attribute__((ext_vector_type(16)));
typedef short bf16x8 __attribute__((ext_vector_type(8)));
typedef float f32x2_t __attribute__((ext_vector_type(2)));
typedef __bf16 bf16x2_t __attribute__((ext_vector_type(2)));
#define LDS_WAIT() asm volatile("s_waitcnt lgkmcnt(0)" ::: "memory")
#define MFMA32(a, b, c) __builtin_amdgcn_mfma_f32_32x32x16_bf16((a), (b), (c), 0, 0, 0)
#define MFMA16(a, b, c) __builtin_amdgcn_mfma_f32_16x16x32_bf16((a), (b), (c), 0, 0, 0)

DI unsigned pk2(float lo, float hi) { f32x2_t v = {lo, hi}; bf16x2_t b = __builtin_convertvector(v, bf16x2_t); return __builtin_bit_cast(unsigned, b); }
DI float bflo(unsigned u) { return __uint_as_float(u << 16); }
DI float bfhi(unsigned u) { return __uint_as_float(u & 0xffff0000u); }
DI float bf2f(bf16 h) { return __uint_as_float(((unsigned)h) << 16); }
DI bf16 f2bf(float f) { return (bf16)(pk2(f, 0.f) & 0xffffu); }
DI float wave_sum(float v) {
#pragma unroll
    for (int o = 1; o < 64; o <<= 1) v += __shfl_xor(v, o);
    return v;
}
DI float silu_f(float x) { return x * __builtin_amdgcn_rcpf(1.0f + __expf(-x)); }
DI int crow(int r, int hi) { return (r & 3) + 8 * (r >> 2) + 4 * hi; }
DI bf16x8 pack8(const f32x4& a, const f32x4& b) { u32x4 p; p.x = pk2(a[0], a[1]); p.y = pk2(a[2], a[3]); p.z = pk2(b[0], b[1]); p.w = pk2(b[2], b[3]); return __builtin_bit_cast(bf16x8, p); }

constexpr int NB = 8, T = 4096, M = NB * T, DM = 1024, FF = 2816;
constexpr float EPS = 1e-6f;
constexpr int NPH = 14;
constexpr int WAVE_LDS = 18944, LDS_BYTES = 8 * WAVE_LDS;

constexpr size_t MiB = 1u << 20;
constexpr size_t SZ_WGU = 5632ull * 1024 * 2, SZ_WD = 1024ull * 2816 * 2, SZ_WIN = 2560ull * 1024 * 2, SZ_WUQ = 768ull * 256 * 2, SZ_WKV = 1024ull * 128 * 2, SZ_WOUT = 1024ull * 1024 * 2;
constexpr size_t WS_W1GU = 0, WS_W1D = WS_W1GU + SZ_WGU, WS_WIN = WS_W1D + SZ_WD, WS_WUQ = WS_WIN + SZ_WIN, WS_WKV = WS_WUQ + SZ_WUQ, WS_WOUT = WS_WKV + SZ_WKV,
                 WS_W2GU = WS_WOUT + SZ_WOUT, WS_W2D = WS_W2GU + SZ_WGU, WS_ROWSQ = WS_W2D + SZ_WD, WS_GLAST = WS_ROWSQ + (size_t)M * 16 * 4, WS_BAR = WS_GLAST + 4096 * 4, WS_RS = WS_BAR + 32768, WS_P = WS_RS + 2 * (size_t)M * 4,
                 WS_Q = WS_P + 64 * MiB, WS_H = WS_Q + 64 * MiB, WS_G = WS_H + 177 * MiB, WS_END = WS_G + 4096ull * 40960;
static_assert(WS_END <= 512 * MiB, "workspace map exceeds the guaranteed 512 MiB");
static_assert((size_t)M * FF * 2 == 176 * MiB, "H region");
constexpr size_t P_CQN = 0, P_CKVN = 16 * MiB, P_MLAO = 24 * MiB;
constexpr size_t H_PS = 0, H_QKV = 64 * MiB, H_KB = 64 * MiB, H_VT = 112 * MiB, H_OG = 145 * MiB;
constexpr int VT_LD = M + 64;
static_assert(512ull * VT_LD * 2 <= 33 * MiB, "Vt slot");

struct Args { const void* in[25]; float* out; unsigned char* ws; int ph_lo, ph_hi; };

DI int wmap(int mode, int n) {
    switch (mode) {
        case 1: return (n >> 7) * 256 + (n & 127);
        case 2: return (n >> 7) * 256 + 128 + (n & 127);
        case 3: return n < 256 ? 512 + n : n < 384 ? 768 + (n - 256) : n < 416 ? 896 + (n - 384) : n < 1952 ? 1024 + (n - 416) : n < 1960 ? 928 + (n - 1952) : n < 1968 ? 936 + (n - 1960) : (n - 1968);
        case 4: { const int h = n >> 7, r = n & 127; return (r < 64 ? 0 : 512) + h * 64 + (r & 63); }
        default: return n;
    }
}
DI void transpose_item(const float* W, int K, int N, bf16* WT, int mode, LAS float* scr, int item, int lane, const float* gk = nullptr) {
    const float wsc = mode == 1 ? -1.4426950408889634f : mode == 2 ? -0.6931471805599453f : 1.0f;
    const int nblk = (N + 31) / 32, kb = item / nblk, nb = item % nblk, k0 = 64 * kb, n0 = 32 * nb;
    f32x4 ld[8];
#pragma unroll
    for (int it = 0; it < 8; ++it) { const int kk = it * 8 + (lane >> 3), n4 = 4 * (lane & 7);
        ld[it] = (n0 + n4 < N) ? *(const f32x4*)(W + (size_t)(k0 + kk) * N + n0 + n4) : (f32x4){0.f, 0.f, 0.f, 0.f}; }
#pragma unroll
    for (int it = 0; it < 8; ++it) { const int kk = it * 8 + (lane >> 3), n4 = 4 * (lane & 7); LAS float* d = scr + kk * 33 + n4;
        d[0] = ld[it][0]; d[1] = ld[it][1]; d[2] = ld[it][2]; d[3] = ld[it][3]; }
    LDS_WAIT();
    const int c = lane & 7;
    float gs[8];
    { f32x4 g0 = {1.f, 1.f, 1.f, 1.f}, g1 = g0; if (gk) { g0 = *(const f32x4*)(gk + k0 + 8 * c); g1 = *(const f32x4*)(gk + k0 + 8 * c + 4); }
      gs[0] = g0[0] * wsc; gs[1] = g0[1] * wsc; gs[2] = g0[2] * wsc; gs[3] = g0[3] * wsc; gs[4] = g1[0] * wsc; gs[5] = g1[1] * wsc; gs[6] = g1[2] * wsc; gs[7] = g1[3] * wsc; }
#pragma unroll
    for (int j = 0; j < 4; ++j) {
        const int n = (lane >> 3) + 8 * j; const LAS float* s = scr + (8 * c) * 33 + n;
        u32x4 o; o.x = pk2(s[0 * 33] * gs[0], s[1 * 33] * gs[1]); o.y = pk2(s[2 * 33] * gs[2], s[3 * 33] * gs[3]); o.z = pk2(s[4 * 33] * gs[4], s[5 * 33] * gs[5]); o.w = pk2(s[6 * 33] * gs[6], s[7 * 33] * gs[7]);
        if (n0 + n < N) *(u32x4*)(WT + (size_t)wmap(mode, n0 + n) * K + k0 + 8 * c) = o;
    }
    LDS_WAIT();
}
template <int NR> DI void rms_rows_to_bf16(const float* x, const float* g, bf16* o, int m0, int mstride, int lane) {
    f32x4 v[NR][4]; float s[NR];
#pragma unroll
    for (int r = 0; r < NR; ++r)
#pragma unroll
        for (int j = 0; j < 4; ++j) v[r][j] = __builtin_nontemporal_load((const f32x4*)(x + (size_t)(m0 + r * mstride) * DM + 4 * lane + 256 * j));
#pragma unroll
    for (int r = 0; r < NR; ++r) { s[r] = 0.f;
#pragma unroll
        for (int j = 0; j < 4; ++j) s[r] += (v[r][j][0] * v[r][j][0] + v[r][j][1] * v[r][j][1]) + (v[r][j][2] * v[r][j][2] + v[r][j][3] * v[r][j][3]); }
#pragma unroll
    for (int r = 0; r < NR; ++r) {
        const float rr = rsqrtf(wave_sum(s[r]) * (1.f / 1024.f) + EPS);
#pragma unroll
        for (int j = 0; j < 4; ++j) { const f32x4 gg = *(const f32x4*)(g + 4 * lane + 256 * j); const f32x4 ov = v[r][j] * rr * gg;
            u32x2 w; w.x = pk2(ov[0], ov[1]); w.y = pk2(ov[2], ov[3]); *(u32x2*)(o + (size_t)(m0 + r * mstride) * DM + 4 * lane + 256 * j) = w; }
    }
}
template <int NR, bool XIN_BF, bool XOUT_BF> DI void resid_rows(const void* xin_, void* xout_, const bf16* d, const float* rsq, float coef, const float* pg, const float* ng, bf16* xn, int m0, int mstride, int lane, float* rs_out = nullptr) {
    f32x4 xv[NR][4]; u32x2 dv[NR][4]; float ss[NR];
#pragma unroll
    for (int r = 0; r < NR; ++r) { const size_t m = (size_t)(m0 + r * mstride);
        ss[r] = lane < 16 ? rsq[m * 16 + lane] : 0.f;
#pragma unroll
        for (int j = 0; j < 4; ++j) { const int c = 4 * lane + 256 * j;
            if (XIN_BF) { const u32x2 t = __builtin_nontemporal_load((const u32x2*)((const bf16*)xin_ + m * DM + c)); xv[r][j] = (f32x4){bflo(t.x), bfhi(t.x), bflo(t.y), bfhi(t.y)}; }
            else xv[r][j] = __builtin_nontemporal_load((const f32x4*)((const float*)xin_ + m * DM + c));
            dv[r][j] = __builtin_nontemporal_load((const u32x2*)(d + m * DM + c)); } }
#pragma unroll
    for (int r = 0; r < NR; ++r) { const size_t m = (size_t)(m0 + r * mstride);
        const float rr = rsqrtf(wave_sum(ss[r]) * (1.f / 1024.f) + EPS) * coef; float s2 = 0.f;
#pragma unroll
        for (int j = 0; j < 4; ++j) { const int c = 4 * lane + 256 * j; const f32x4 gg = *(const f32x4*)(pg + c);
            const f32x4 df = {bflo(dv[r][j].x), bfhi(dv[r][j].x), bflo(dv[r][j].y), bfhi(dv[r][j].y)};
            xv[r][j] = xv[r][j] + df * rr * gg;
            if (XOUT_BF) { u32x2 w; w.x = pk2(xv[r][j][0], xv[r][j][1]); w.y = pk2(xv[r][j][2], xv[r][j][3]); *(u32x2*)((bf16*)xout_ + m * DM + c) = w; }
            else __builtin_nontemporal_store(xv[r][j], (f32x4*)((float*)xout_ + m * DM + c));
            s2 += (xv[r][j][0] * xv[r][j][0] + xv[r][j][1] * xv[r][j][1]) + (xv[r][j][2] * xv[r][j][2] + xv[r][j][3] * xv[r][j][3]); }
        if (rs_out) { const float r2 = rsqrtf(wave_sum(s2) * (1.f / 1024.f) + EPS); if (lane == 0) rs_out[m] = r2; }
        if (xn) {
            const float r2 = rsqrtf(wave_sum(s2) * (1.f / 1024.f) + EPS);
#pragma unroll
            for (int j = 0; j < 4; ++j) { const int c = 4 * lane + 256 * j; const f32x4 gg = *(const f32x4*)(ng + c); const f32x4 o = xv[r][j] * r2 * gg;
                u32x2 w; w.x = pk2(o[0], o[1]); w.y = pk2(o[2], o[3]); *(u32x2*)(xn + m * DM + c) = w; }
        }
    }
}
DI void rope_cs(int pos, int j, float& c, float& s) {
    const int jl = j & 3, jh = j >> 2;
    const double fb = jl == 0 ? 1.0 : jl == 1 ? 0.5623413251903491 : jl == 2 ? 0.31622776601683794 : 0.1778279410038923;
    const double fs = jh == 0 ? 1.0 : jh == 1 ? 0.1 : jh == 2 ? 0.01 : 0.001;
    double a = (double)pos * (fb * fs) * 0.15915494309189535;
    a -= __builtin_rint(a);
    const float fr = (float)a;
    c = __builtin_amdgcn_cosf(fr); s = __builtin_amdgcn_sinf(fr);
}
template <int NR> DI void e2_rows(const bf16* PS, const float* gq, const float* gkv, bf16* CQN, bf16* CKVN, int m0, int mstride, int lane) {
    u32x2 a[NR]; unsigned bq[NR];
#pragma unroll
    for (int r = 0; r < NR; ++r) { const bf16* ps = PS + (size_t)(m0 + r * mstride) * 1024; a[r] = *(const u32x2*)(ps + 512 + 4 * lane); bq[r] = *(const unsigned*)(ps + 768 + 2 * lane); }
    const f32x4 g = *(const f32x4*)(gq + 4 * lane); const float g0 = gkv[2 * lane], g1 = gkv[2 * lane + 1];
#pragma unroll
    for (int r = 0; r < NR; ++r) { const size_t m = (size_t)(m0 + r * mstride);
        f32x4 v = {bflo(a[r].x), bfhi(a[r].x), bflo(a[r].y), bfhi(a[r].y)};
        float rr = rsqrtf(wave_sum((v[0] * v[0] + v[1] * v[1]) + (v[2] * v[2] + v[3] * v[3])) * (1.f / 256.f) + EPS);
        v = v * rr * g;
        u32x2 w; w.x = pk2(v[0], v[1]); w.y = pk2(v[2], v[3]); *(u32x2*)(CQN + m * 256 + 4 * lane) = w;
        const float k0 = bflo(bq[r]), k1 = bfhi(bq[r]);
        rr = rsqrtf(wave_sum(k0 * k0 + k1 * k1) * (1.f / 128.f) + EPS);
        *(unsigned*)(CKVN + m * 128 + 2 * lane) = pk2(k0 * rr * g0, k1 * rr * g1); }
}
template <int NR> DI void kpe_rows(const bf16* PS, const int* positions, bf16* KB, int m0, int mstride, int lane) {
    const int j = lane & 15, hh = lane >> 4;
    bf16 a1[NR], a2[NR]; int pos[NR];
#pragma unroll
    for (int r = 0; r < NR; ++r) { const size_t m = (size_t)(m0 + r * mstride); a1[r] = PS[m * 1024 + 896 + j]; a2[r] = PS[m * 1024 + 912 + j]; pos[r] = positions[m]; }
#pragma unroll
    for (int r = 0; r < NR; ++r) { const size_t m = (size_t)(m0 + r * mstride);
        const float x1 = bf2f(a1[r]), x2 = bf2f(a2[r]);
        float c, s; rope_cs(pos[r], j, c, s);
        const bf16 o1 = f2bf(x1 * c - x2 * s), o2 = f2bf(x1 * s + x2 * c);
        bf16* krow = KB + m * 768;
        krow[hh * 96 + 64 + j] = o1; krow[hh * 96 + 80 + j] = o2;
        krow[(hh + 4) * 96 + 64 + j] = o1; krow[(hh + 4) * 96 + 80 + j] = o2; }
}
template <int NR> DI void mix_rows(const bf16* MLA, const bf16* OGp, const bf16* GATE, const float* g_mla, const float* g_gdn, bf16* OUT, int m0, int mstride, int lane) {
    u32x4 am[NR], ao[NR], ag[NR];
#pragma unroll
    for (int r = 0; r < NR; ++r) { const size_t m = (size_t)(m0 + r * mstride);
        am[r] = *(const u32x4*)(MLA + m * 512 + 8 * lane); ao[r] = *(const u32x4*)(OGp + m * 512 + 8 * lane); ag[r] = *(const u32x4*)(GATE + m * 1024 + 8 * lane); }
    const f32x4 gm0 = *(const f32x4*)(g_mla + 8 * lane), gm1 = *(const f32x4*)(g_mla + 8 * lane + 4);
    const int e0 = 8 * (lane & 7);
    const f32x4 gd0 = *(const f32x4*)(g_gdn + e0), gd1 = *(const f32x4*)(g_gdn + e0 + 4);
    const float gm[8] = {gm0[0], gm0[1], gm0[2], gm0[3], gm1[0], gm1[1], gm1[2], gm1[3]};
    const float gd[8] = {gd0[0], gd0[1], gd0[2], gd0[3], gd1[0], gd1[1], gd1[2], gd1[3]};
#pragma unroll
    for (int r = 0; r < NR; ++r) { const size_t m = (size_t)(m0 + r * mstride);
        {
            const u32x4 a = am[r];
            float v[8] = {bflo(a.x), bfhi(a.x), bflo(a.y), bfhi(a.y), bflo(a.z), bfhi(a.z), bflo(a.w), bfhi(a.w)};
            float s2 = 0.f;
#pragma unroll
            for (int i = 0; i < 8; ++i) s2 += v[i] * v[i];
            const float rr = rsqrtf(wave_sum(s2) * (1.f / 512.f) + EPS);
            u32x4 w; w.x = pk2(v[0] * rr * gm[0], v[1] * rr * gm[1]); w.y = pk2(v[2] * rr * gm[2], v[3] * rr * gm[3]); w.z = pk2(v[4] * rr * gm[4], v[5] * rr * gm[5]); w.w = pk2(v[6] * rr * gm[6], v[7] * rr * gm[7]);
            *(u32x4*)(OUT + m * 1024 + 8 * lane) = w;
        }
        {
            const u32x4 a = ao[r], gt = ag[r];
            float v[8] = {bflo(a.x), bfhi(a.x), bflo(a.y), bfhi(a.y), bflo(a.z), bfhi(a.z), bflo(a.w), bfhi(a.w)};
            float gv[8] = {bflo(gt.x), bfhi(gt.x), bflo(gt.y), bfhi(gt.y), bflo(gt.z), bfhi(gt.z), bflo(gt.w), bfhi(gt.w)};
            float s2 = 0.f;
#pragma unroll
            for (int i = 0; i < 8; ++i) s2 += v[i] * v[i];
            s2 += __shfl_xor(s2, 1); s2 += __shfl_xor(s2, 2); s2 += __shfl_xor(s2, 4);
            const float rr = rsqrtf(s2 * (1.f / 64.f) + EPS);
            float o[8];
#pragma unroll
            for (int i = 0; i < 8; ++i) o[i] = v[i] * rr * gd[i] * silu_f(gv[i]);
            u32x4 w; w.x = pk2(o[0], o[1]); w.y = pk2(o[2], o[3]); w.z = pk2(o[4], o[5]); w.w = pk2(o[6], o[7]);
            *(u32x4*)(OUT + m * 1024 + 512 + 8 * lane) = w;
        }
    }
}

template <int NR> DI void mla_norm_rows(bf16* A, const float* g_mla, int m0, int mstride, int lane) {
    u32x4 am[NR];
#pragma unroll
    for (int r = 0; r < NR; ++r) am[r] = *(const u32x4*)(A + (size_t)(m0 + r * mstride) * 1024 + 8 * lane);
    const f32x4 gm0 = *(const f32x4*)(g_mla + 8 * lane), gm1 = *(const f32x4*)(g_mla + 8 * lane + 4);
    const float gm[8] = {gm0[0], gm0[1], gm0[2], gm0[3], gm1[0], gm1[1], gm1[2], gm1[3]};
#pragma unroll
    for (int r = 0; r < NR; ++r) {
        const u32x4 a = am[r];
        float v[8] = {bflo(a.x), bfhi(a.x), bflo(a.y), bfhi(a.y), bflo(a.z), bfhi(a.z), bflo(a.w), bfhi(a.w)};
        float s2 = 0.f;
#pragma unroll
        for (int i = 0; i < 8; ++i) s2 += v[i] * v[i];
        const float rr = rsqrtf(wave_sum(s2) * (1.f / 512.f) + EPS);
        u32x4 w; w.x = pk2(v[0] * rr * gm[0], v[1] * rr * gm[1]); w.y = pk2(v[2] * rr * gm[2], v[3] * rr * gm[3]); w.z = pk2(v[4] * rr * gm[4], v[5] * rr * gm[5]); w.w = pk2(v[6] * rr * gm[6], v[7] * rr * gm[7]);
        *(u32x4*)(A + (size_t)(m0 + r * mstride) * 1024 + 8 * lane) = w;
    }
}
DI void conv_row(const bf16* qkv, int row0, int n, int coff, const float* cw, LAS unsigned char* R, LAS unsigned char* HX, int lane, float (&y)[64]) {
    const __attribute__((address_space(4))) float* cw4 = (const __attribute__((address_space(4))) float*)(uintptr_t)cw;
#pragma unroll
    for (int it = 0; it < 8; ++it) { const int r = it * 8 + (lane >> 3), c8 = lane & 7;
        const u32x4 v = *(const u32x4*)(qkv + (size_t)(row0 + r) * 1536 + coff + c8 * 8); *(LAS u32x4*)(R + r * 144 + c8 * 16) = v; }
    {
        const int hr = lane >> 3, c8 = lane & 7;
        u32x4 v = {0u, 0u, 0u, 0u};
        if (lane < 24 && n > 0) v = *(const u32x4*)(qkv + (size_t)(row0 - 3 + hr) * 1536 + coff + c8 * 8);
        if (lane < 24) *(LAS u32x4*)(HX + hr * 144 + c8 * 16) = v;
    }
    LDS_WAIT();
    const LAS unsigned char* tp[4];
#pragma unroll
    for (int j = 0; j < 4; ++j) { const int tr = lane - 3 + j; tp[j] = tr >= 0 ? (const LAS unsigned char*)(R + tr * 144) : (const LAS unsigned char*)(HX + (tr + 3) * 144); }
#pragma unroll
    for (int c8 = 0; c8 < 8; ++c8) {
        float acc[8];
#pragma unroll
        for (int i = 0; i < 8; ++i) acc[i] = 0.f;
#pragma unroll
        for (int j = 0; j < 4; ++j) {
            const u32x4 xv = *(const LAS u32x4*)(tp[j] + c8 * 16);
            float w[8];
#pragma unroll
            for (int i = 0; i < 8; ++i) w[i] = cw4[j * 1536 + c8 * 8 + i];
            acc[0] += w[0] * bflo(xv.x); acc[1] += w[1] * bfhi(xv.x); acc[2] += w[2] * bflo(xv.y); acc[3] += w[3] * bfhi(xv.y);
            acc[4] += w[4] * bflo(xv.z); acc[5] += w[5] * bfhi(xv.z); acc[6] += w[6] * bflo(xv.w); acc[7] += w[7] * bfhi(xv.w);
        }
#pragma unroll
        for (int i = 0; i < 8; ++i) y[c8 * 8 + i] = silu_f(acc[i]);
    }
    LDS_WAIT();
}
DI void copy_out(const LAS unsigned char* R, bf16* g, int lane) {
#pragma unroll
    for (int it = 0; it < 8; ++it) { const int r = it * 8 + (lane >> 3), c8 = lane & 7; *(u32x4*)(g + r * 64 + c8 * 8) = *(const LAS u32x4*)(R + r * 144 + c8 * 16); }
}
DI void gdn_prep_unit(int uid, const bf16* qkv, const bf16* psmall, const float* convw, const float* a_log, const float* dt_bias,
                      unsigned char* G, float* glast, LAS unsigned char* wl, int lane) {
    asm volatile("" : "+v"(lane));
    asm volatile("" : "+s"(uid));
    const int h = uid & 7, n = (uid >> 3) & 63, b = uid >> 9;
    const int row0 = b * T + 64 * n;
    const int r32 = lane & 31, hi = lane >> 5;
    unsigned char* Gu = G + (size_t)uid * 40960;
    bf16* Wn = (bf16*)Gu; bf16* QD = Wn + 4096; bf16* AT = QD + 4096; bf16* KDT = AT + 4096; bf16* UT = KDT + 4096;
    LAS unsigned char* R0 = wl; LAS unsigned char* R1 = wl + 9216; LAS unsigned char* HX = wl + 18432;
    const bf16* pr = psmall + (size_t)(row0 + lane) * 1024;
    const float xa = bf2f(pr[928 + h]) + dt_bias[h], xb = bf2f(pr[936 + h]);
    const float sp = xa > 20.f ? xa : log1pf(__expf(xa));
    const float g = -__expf(a_log[h]) * sp;
    const float beta = 1.f / (1.f + __expf(-xb));
    float gc = g;
#pragma unroll
    for (int o = 1; o < 64; o <<= 1) { const float v = __shfl_up(gc, o); if (lane >= o) gc += v; }
    const float gl = __shfl(gc, 63);
    const float eg = __expf(gc);
#pragma unroll 1
    for (int mt = 0; mt < 3; ++mt) {
        const int coff = (mt == 0 ? 1024 : mt == 1 ? 512 : 0) + h * 64;
        LAS unsigned char* R = mt == 2 ? R1 : R0;
        float y[64]; conv_row(qkv, row0, n, coff, convw + coff, R, HX, lane, y);
        float ss = 0.f;
#pragma unroll
        for (int i = 0; i < 64; ++i) ss += y[i] * y[i];
        const float rn = mt == 0 ? beta : rsqrtf(ss + EPS) * (mt == 2 ? 0.125f : 1.f);
#pragma unroll
        for (int c8 = 0; c8 < 8; ++c8) {
            u32x4 w;
            w.x = pk2(y[8 * c8] * rn, y[8 * c8 + 1] * rn); w.y = pk2(y[8 * c8 + 2] * rn, y[8 * c8 + 3] * rn); w.z = pk2(y[8 * c8 + 4] * rn, y[8 * c8 + 5] * rn); w.w = pk2(y[8 * c8 + 6] * rn, y[8 * c8 + 7] * rn);
            *(LAS u32x4*)(R + lane * 144 + c8 * 16) = w;
        }
        LDS_WAIT();
        if (mt == 2) {
#pragma unroll
            for (int it = 0; it < 8; ++it) { const int r = it * 8 + (lane >> 3), c8 = lane & 7; const u32x4 v = *(const LAS u32x4*)(R + r * 144 + c8 * 16); const float er = __shfl(eg, r);
                u32x4 w; w.x = pk2(bflo(v.x) * er, bfhi(v.x) * er); w.y = pk2(bflo(v.y) * er, bfhi(v.y) * er); w.z = pk2(bflo(v.z) * er, bfhi(v.z) * er); w.w = pk2(bflo(v.w) * er, bfhi(v.w) * er);
                *(u32x4*)(QD + r * 64 + c8 * 8) = w; }
        } else copy_out(R, mt == 0 ? UT : Wn, lane);
        asm volatile("" ::: "memory");
    }
    LDS_WAIT(); asm volatile("" ::: "memory");
    bf16x8 kf[2][4];
#pragma unroll
    for (int rb = 0; rb < 2; ++rb)
#pragma unroll
        for (int ks = 0; ks < 4; ++ks) kf[rb][ks] = *(const LAS bf16x8*)(R0 + (32 * rb + r32) * 144 + (16 * ks + 8 * hi) * 2);
    {
        bf16x8 qf[2][4];
#pragma unroll
        for (int rb = 0; rb < 2; ++rb)
#pragma unroll
            for (int ks = 0; ks < 4; ++ks) qf[rb][ks] = *(const LAS bf16x8*)(R1 + (32 * rb + r32) * 144 + (16 * ks + 8 * hi) * 2);
        f32x16 d00 = {}, d01 = {}, d11 = {};
#pragma unroll
        for (int ks = 0; ks < 4; ++ks) { d00 = MFMA32(kf[0][ks], qf[0][ks], d00); d01 = MFMA32(kf[0][ks], qf[1][ks], d01); d11 = MFMA32(kf[1][ks], qf[1][ks], d11); }
        LDS_WAIT(); asm volatile("" ::: "memory");
#pragma unroll
        for (int blk = 0; blk < 4; ++blk) {
            const int jb = blk >> 1, ib = (blk == 1 || blk == 2) ? 1 : 0;
            const int i = 32 * ib + r32; const float gci = __shfl(gc, i);
#pragma unroll
            for (int g4 = 0; g4 < 4; ++g4) {
                const int j0 = 32 * jb + 8 * g4 + 4 * hi; float v[4];
#pragma unroll
                for (int e = 0; e < 4; ++e) {
                    const int j = j0 + e; const float gcj = __shfl(gc, j);
                    const float dv = blk == 0 ? d00[4 * g4 + e] : blk == 1 ? d01[4 * g4 + e] : blk == 2 ? d11[4 * g4 + e] : 0.f;
                    v[e] = (j <= i) ? dv * __expf(gci - gcj) : 0.f;
                }
                u32x2 w; w.x = pk2(v[0], v[1]); w.y = pk2(v[2], v[3]); *(LAS u32x2*)(R1 + i * 144 + j0 * 2) = w;
            }
        }
        LDS_WAIT();
        copy_out(R1, AT, lane);
    }
    LDS_WAIT(); asm volatile("" ::: "memory");
    {
        f32x16 e00 = {}, e10 = {}, e11 = {};
#pragma unroll
        for (int ks = 0; ks < 4; ++ks) { e00 = MFMA32(kf[0][ks], kf[0][ks], e00); e10 = MFMA32(kf[1][ks], kf[0][ks], e10); e11 = MFMA32(kf[1][ks], kf[1][ks], e11); }
#pragma unroll
        for (int blk = 0; blk < 3; ++blk) {
            const int ab = blk >= 1 ? 1 : 0, bb = blk == 2 ? 1 : 0;
            const int bcol = 32 * bb + r32; const float gcb = __shfl(gc, bcol);
#pragma unroll
            for (int g4 = 0; g4 < 4; ++g4) {
                const int a0 = 32 * ab + 8 * g4 + 4 * hi; f32x4 v;
#pragma unroll
                for (int e = 0; e < 4; ++e) {
                    const int a = a0 + e; const float gca = __shfl(gc, a), ba = __shfl(beta, a);
                    const float dv = blk == 0 ? e00[4 * g4 + e] : blk == 1 ? e10[4 * g4 + e] : e11[4 * g4 + e];
                    v[e] = (a > bcol) ? dv * ba * __expf(gca - gcb) : 0.f;
                }
                *(LAS f32x4*)(R0 + (bcol * 64 + a0) * 4) = v;
            }
        }
    }
    LDS_WAIT();
    u32x4 kp[8];
#pragma unroll
    for (int it = 0; it < 8; ++it) { const int r = it * 8 + (lane >> 3), c8 = lane & 7; kp[it] = *(const u32x4*)(Wn + r * 64 + c8 * 8); }
    {
        const int blk = lane >> 5, il = lane & 31;
        const LAS unsigned char* LTb = R0 + blk * 8320;
        float Tr[32];
#pragma unroll
        for (int c = 31; c >= 0; --c) {
            float acc = (il == c) ? 1.f : 0.f;
#pragma unroll
            for (int j4 = ((c + 1) / 4) * 4; j4 < 32; j4 += 4) {
                const f32x4 l = *(const LAS f32x4*)(LTb + (c * 64 + j4) * 4);
#pragma unroll
                for (int jj = 0; jj < 4; ++jj) if (j4 + jj > c) acc -= Tr[j4 + jj] * l[jj];
            }
            Tr[c] = acc;
            if ((c & 3) == 0) asm volatile("" ::: "memory");
        }
        bf16x8 a21[2];
#pragma unroll
        for (int ks = 0; ks < 2; ++ks) {
            float t[8];
#pragma unroll
            for (int i = 0; i < 8; ++i) t[i] = *(const LAS float*)(R0 + ((16 * ks + 8 * hi + i) * 64 + 32 + r32) * 4);
            u32x4 p; p.x = pk2(t[0], t[1]); p.y = pk2(t[2], t[3]); p.z = pk2(t[4], t[5]); p.w = pk2(t[6], t[7]); a21[ks] = __builtin_bit_cast(bf16x8, p);
        }
        LDS_WAIT();
#pragma unroll
        for (int c8 = 0; c8 < 4; ++c8) {
            u32x4 w; w.x = pk2(Tr[8 * c8], Tr[8 * c8 + 1]); w.y = pk2(Tr[8 * c8 + 2], Tr[8 * c8 + 3]); w.z = pk2(Tr[8 * c8 + 4], Tr[8 * c8 + 5]); w.w = pk2(Tr[8 * c8 + 6], Tr[8 * c8 + 7]);
            *(LAS u32x4*)(R0 + lane * 144 + (32 * blk + 8 * c8) * 2) = w;
            *(LAS u32x4*)(R0 + lane * 144 + (32 * (1 - blk) + 8 * c8) * 2) = (u32x4){0u, 0u, 0u, 0u};
        }
        LDS_WAIT();
        f32x16 X = {};
#pragma unroll
        for (int ks = 0; ks < 2; ++ks) {
            unsigned short t[8];
#pragma unroll
            for (int i = 0; i < 8; ++i) t[i] = *(const LAS unsigned short*)(R0 + (16 * ks + 8 * hi + i) * 144 + r32 * 2);
            u32x4 p; p.x = t[0] | ((unsigned)t[1] << 16); p.y = t[2] | ((unsigned)t[3] << 16); p.z = t[4] | ((unsigned)t[5] << 16); p.w = t[6] | ((unsigned)t[7] << 16);
            X = MFMA32(a21[ks], __builtin_bit_cast(bf16x8, p), X);
        }
        f32x16 Y = {};
#pragma unroll
        for (int sstep = 0; sstep < 2; ++sstep) {
            u32x4 xb; xb.x = pk2(X[8 * sstep], X[8 * sstep + 1]); xb.y = pk2(X[8 * sstep + 2], X[8 * sstep + 3]); xb.z = pk2(X[8 * sstep + 4], X[8 * sstep + 5]); xb.w = pk2(X[8 * sstep + 6], X[8 * sstep + 7]);
            const LAS unsigned char* ap = R0 + (32 + r32) * 144 + (32 + 16 * sstep + 4 * hi) * 2;
            const u32x2 lo = *(const LAS u32x2*)ap, hi2 = *(const LAS u32x2*)(ap + 16);
            u32x4 av = {lo.x, lo.y, hi2.x, hi2.y};
            Y = MFMA32(__builtin_bit_cast(bf16x8, av), __builtin_bit_cast(bf16x8, xb), Y);
        }
        LDS_WAIT();
#pragma unroll
        for (int r = 0; r < 16; ++r) *(LAS bf16*)(R0 + (32 + crow(r, hi)) * 144 + r32 * 2) = f2bf(-Y[r]);
    }
    LDS_WAIT();
    {
        const float scl = beta * eg;
#pragma unroll
        for (int it = 0; it < 8; ++it) { const int r = it * 8 + (lane >> 3), c8 = lane & 7; const float sr = __shfl(scl, r);
            LAS unsigned char* d = R1 + (8 * c8) * 144 + r * 2;
            *(LAS bf16*)(d) = f2bf(bflo(kp[it].x) * sr); *(LAS bf16*)(d + 144) = f2bf(bfhi(kp[it].x) * sr); *(LAS bf16*)(d + 288) = f2bf(bflo(kp[it].y) * sr); *(LAS bf16*)(d + 432) = f2bf(bfhi(kp[it].y) * sr);
            *(LAS bf16*)(d + 576) = f2bf(bflo(kp[it].z) * sr); *(LAS bf16*)(d + 720) = f2bf(bfhi(kp[it].z) * sr); *(LAS bf16*)(d + 864) = f2bf(bflo(kp[it].w) * sr); *(LAS bf16*)(d + 1008) = f2bf(bfhi(kp[it].w) * sr); }
    }
    LDS_WAIT();
    u32x4 vp[8];
#pragma unroll
    for (int it = 0; it < 8; ++it) { const int r = it * 8 + (lane >> 3), c8 = lane & 7; vp[it] = *(const u32x4*)(UT + r * 64 + c8 * 8); }
    bf16x8 tf[2][4];
#pragma unroll
    for (int rb = 0; rb < 2; ++rb)
#pragma unroll
        for (int ks = 0; ks < 4; ++ks) tf[rb][ks] = *(const LAS bf16x8*)(R0 + (32 * rb + r32) * 144 + (16 * ks + 8 * hi) * 2);
    {
        bf16x8 rt[2][4];
#pragma unroll
        for (int db = 0; db < 2; ++db)
#pragma unroll
            for (int ks = 0; ks < 4; ++ks) rt[db][ks] = *(const LAS bf16x8*)(R1 + (32 * db + r32) * 144 + (16 * ks + 8 * hi) * 2);
        LDS_WAIT(); asm volatile("" ::: "memory");
#pragma unroll
        for (int db = 0; db < 2; ++db)
#pragma unroll
            for (int ib = 0; ib < 2; ++ib) {
                f32x16 d = {};
#pragma unroll
                for (int ks = 0; ks < 4; ++ks) if (ib == 1 || ks < 2) d = MFMA32(rt[db][ks], tf[ib][ks], d);
                const int i = 32 * ib + r32;
#pragma unroll
                for (int g4 = 0; g4 < 4; ++g4) { const int d0 = 32 * db + 8 * g4 + 4 * hi;
                    u32x2 w; w.x = pk2(-d[4 * g4], -d[4 * g4 + 1]); w.y = pk2(-d[4 * g4 + 2], -d[4 * g4 + 3]); *(LAS u32x2*)(R1 + i * 144 + d0 * 2) = w; }
            }
        LDS_WAIT();
        copy_out(R1, Wn, lane);
    }
    LDS_WAIT(); asm volatile("" ::: "memory");
    {
        const float kd = __expf(gl - gc);
#pragma unroll
        for (int it = 0; it < 8; ++it) { const int r = it * 8 + (lane >> 3), c8 = lane & 7; const float sr = __shfl(kd, r);
            LAS unsigned char* d = R1 + (8 * c8) * 144 + r * 2;
            *(LAS bf16*)(d) = f2bf(bflo(kp[it].x) * sr); *(LAS bf16*)(d + 144) = f2bf(bfhi(kp[it].x) * sr); *(LAS bf16*)(d + 288) = f2bf(bflo(kp[it].y) * sr); *(LAS bf16*)(d + 432) = f2bf(bfhi(kp[it].y) * sr);
            *(LAS bf16*)(d + 576) = f2bf(bflo(kp[it].z) * sr); *(LAS bf16*)(d + 720) = f2bf(bfhi(kp[it].z) * sr); *(LAS bf16*)(d + 864) = f2bf(bflo(kp[it].w) * sr); *(LAS bf16*)(d + 1008) = f2bf(bfhi(kp[it].w) * sr); }
        LDS_WAIT();
        copy_out(R1, KDT, lane);
    }
    LDS_WAIT(); asm volatile("" ::: "memory");
    {
#pragma unroll
        for (int it = 0; it < 8; ++it) { const int r = it * 8 + (lane >> 3), c8 = lane & 7;
            LAS unsigned char* d = R1 + (8 * c8) * 144 + r * 2;
            *(LAS bf16*)(d) = (bf16)(vp[it].x & 0xffffu); *(LAS bf16*)(d + 144) = (bf16)(vp[it].x >> 16); *(LAS bf16*)(d + 288) = (bf16)(vp[it].y & 0xffffu); *(LAS bf16*)(d + 432) = (bf16)(vp[it].y >> 16);
            *(LAS bf16*)(d + 576) = (bf16)(vp[it].z & 0xffffu); *(LAS bf16*)(d + 720) = (bf16)(vp[it].z >> 16); *(LAS bf16*)(d + 864) = (bf16)(vp[it].w & 0xffffu); *(LAS bf16*)(d + 1008) = (bf16)(vp[it].w >> 16); }
        LDS_WAIT();
        bf16x8 rt[2][4];
#pragma unroll
        for (int eb = 0; eb < 2; ++eb)
#pragma unroll
            for (int ks = 0; ks < 4; ++ks) rt[eb][ks] = *(const LAS bf16x8*)(R1 + (32 * eb + r32) * 144 + (16 * ks + 8 * hi) * 2);
        LDS_WAIT(); asm volatile("" ::: "memory");
#pragma unroll
        for (int eb = 0; eb < 2; ++eb)
#pragma unroll
            for (int ib = 0; ib < 2; ++ib) {
                f32x16 d = {};
#pragma unroll
                for (int ks = 0; ks < 4; ++ks) if (ib == 1 || ks < 2) d = MFMA32(tf[ib][ks], rt[eb][ks], d);
                const int e = 32 * eb + r32;
#pragma unroll
                for (int g4 = 0; g4 < 4; ++g4) { const int i0 = 32 * ib + 8 * g4 + 4 * hi;
                    u32x2 w; w.x = pk2(d[4 * g4], d[4 * g4 + 1]); w.y = pk2(d[4 * g4 + 2], d[4 * g4 + 3]); *(LAS u32x2*)(R1 + e * 144 + i0 * 2) = w; }
            }
        LDS_WAIT();
        copy_out(R1, UT, lane);
    }
    if (lane == 0) glast[uid] = __expf(gl);
    LDS_WAIT();
}
DI bf16x8 frag_a16(const LAS unsigned char* Mat, int mb, int ks, int m16, int q4) {
    const LAS unsigned char* p = Mat + (16 * mb + m16) * 144 + (32 * ks + 4 * q4) * 2;
    const u32x2 lo = *(const LAS u32x2*)p, hi = *(const LAS u32x2*)(p + 32);
    u32x4 v = {lo.x, lo.y, hi.x, hi.y}; return __builtin_bit_cast(bf16x8, v);
}
DI void gdn_scan(int b, int h, const unsigned char* G, const float* glast, const bf16* PSg, const float* g_gdn, bf16* MIXA, LAS unsigned char* lds, int tid) {
    const int wave = __builtin_amdgcn_readfirstlane(tid >> 6), lane = tid & 63, m16 = lane & 15, q4 = lane >> 4;
    const int prow = tid >> 3, pc = tid & 7;
    const int e = 16 * (wave & 3) + m16;
    f32x4 S[4];
#pragma unroll
    for (int i = 0; i < 4; ++i) S[i] = (f32x4){0.f, 0.f, 0.f, 0.f};
    u32x4 pA[4], pB[4]; u32x2 un[4]; float gln; u32x4 gt[2];
    const unsigned char* G0 = G + (size_t)(b * 512 + h) * 40960;
    const int fr0 = (tid & 255) >> 3, fc8 = tid & 7;
    float gd[8];
    { const f32x4 g0 = *(const f32x4*)(g_gdn + 8 * fc8), g1 = *(const f32x4*)(g_gdn + 8 * fc8 + 4); gd[0] = g0[0]; gd[1] = g0[1]; gd[2] = g0[2]; gd[3] = g0[3]; gd[4] = g1[0]; gd[5] = g1[1]; gd[6] = g1[2]; gd[7] = g1[3]; }
#define SC_ISSUE(P, n) do { const int nn_ = (n) < 64 ? (n) : 63; const unsigned char* Gn_ = G0 + (size_t)nn_ * (8 * 40960); _Pragma("unroll") for (int mt = 0; mt < 4; ++mt) P[mt] = *(const u32x4*)(Gn_ + mt * 8192 + tid * 16); } while (0)
#define SC_COMMIT(P, stage) do { LAS unsigned char* nb_ = lds + (stage) * 36864; _Pragma("unroll") for (int mt = 0; mt < 4; ++mt) *(LAS u32x4*)(nb_ + mt * 9216 + prow * 144 + pc * 16) = P[mt]; } while (0)
#define SC_UNEXT(n) do { const int nn_ = (n) < 64 ? (n) : 63; const bf16* UT_ = (const bf16*)(G0 + (size_t)nn_ * (8 * 40960) + 32768); _Pragma("unroll") for (int mb = 0; mb < 4; ++mb) un[mb] = *(const u32x2*)(UT_ + e * 64 + 16 * mb + 4 * q4); gln = glast[(b * 64 + nn_) * 8 + h]; } while (0)
#define SC_GATE(n) do { const int nn_ = (n) < 64 ? (n) : 63; _Pragma("unroll") for (int pp_ = 0; pp_ < 2; ++pp_) gt[pp_] = *(const u32x4*)(PSg + (size_t)(b * T + 64 * nn_ + fr0 + 32 * pp_) * 1024 + h * 64 + 8 * fc8); } while (0)
#define SC_FLUSH(n, stage) do { if (wave >= 4) { _Pragma("unroll") for (int pp_ = 0; pp_ < 2; ++pp_) { const int r_ = fr0 + 32 * pp_; \
        const u32x4 a_ = *(const LAS u32x4*)(lds + 73728 + (stage) * 9216 + r_ * 144 + fc8 * 16); const u32x4 g_ = gt[pp_]; \
        float v_[8] = {bflo(a_.x), bfhi(a_.x), bflo(a_.y), bfhi(a_.y), bflo(a_.z), bfhi(a_.z), bflo(a_.w), bfhi(a_.w)}; \
        float gv_[8] = {bflo(g_.x), bfhi(g_.x), bflo(g_.y), bfhi(g_.y), bflo(g_.z), bfhi(g_.z), bflo(g_.w), bfhi(g_.w)}; \
        float s2_ = 0.f; _Pragma("unroll") for (int i_ = 0; i_ < 8; ++i_) s2_ += v_[i_] * v_[i_]; \
        s2_ += __shfl_xor(s2_, 1); s2_ += __shfl_xor(s2_, 2); s2_ += __shfl_xor(s2_, 4); \
        const float rr_ = rsqrtf(s2_ * (1.f / 64.f) + EPS); float o_[8]; \
        _Pragma("unroll") for (int i_ = 0; i_ < 8; ++i_) o_[i_] = v_[i_] * rr_ * gd[i_] * silu_f(gv_[i_]); \
        u32x4 w_; w_.x = pk2(o_[0], o_[1]); w_.y = pk2(o_[2], o_[3]); w_.z = pk2(o_[4], o_[5]); w_.w = pk2(o_[6], o_[7]); \
        *(u32x4*)(MIXA + (size_t)(b * T + 64 * (n) + r_) * 1024 + 512 + h * 64 + 8 * fc8) = w_; } } } while (0)
#define SC_COMPUTE(n, stage) do { \
        f32x4 vn[4]; _Pragma("unroll") for (int mb = 0; mb < 4; ++mb) vn[mb] = (f32x4){bflo(un[mb].x), bfhi(un[mb].x), bflo(un[mb].y), bfhi(un[mb].y)}; \
        const float gl = gln; \
        SC_UNEXT((n) + 1);        \
        if (wave < 4) { \
        const LAS unsigned char* base = lds + (stage) * 36864; \
        bf16x8 bS[2], bV[2]; bS[0] = pack8(S[0], S[1]); bS[1] = pack8(S[2], S[3]); \
        _Pragma("unroll") for (int mb = 0; mb < 4; ++mb) _Pragma("unroll") for (int ks = 0; ks < 2; ++ks) vn[mb] = MFMA16(frag_a16(base, mb, ks, m16, q4), bS[ks], vn[mb]); \
        bV[0] = pack8(vn[0], vn[1]); bV[1] = pack8(vn[2], vn[3]); \
        _Pragma("unroll") for (int mb = 0; mb < 4; ++mb) { f32x4 o = {0.f, 0.f, 0.f, 0.f}; \
            _Pragma("unroll") for (int ks = 0; ks < 2; ++ks) { o = MFMA16(frag_a16(base + 9216, mb, ks, m16, q4), bS[ks], o); o = MFMA16(frag_a16(base + 18432, mb, ks, m16, q4), bV[ks], o); } \
            LAS unsigned char* op = lds + 73728 + (stage) * 9216 + (16 * mb + 4 * q4) * 144 + e * 2;     \
            *(LAS bf16*)(op) = f2bf(o[0]); *(LAS bf16*)(op + 144) = f2bf(o[1]); *(LAS bf16*)(op + 288) = f2bf(o[2]); *(LAS bf16*)(op + 432) = f2bf(o[3]); } \
        _Pragma("unroll") for (int mb = 0; mb < 4; ++mb) { S[mb] = S[mb] * gl; \
            _Pragma("unroll") for (int ks = 0; ks < 2; ++ks) S[mb] = MFMA16(frag_a16(base + 27648, mb, ks, m16, q4), bV[ks], S[mb]); } } } while (0)
    SC_ISSUE(pA, 0); SC_ISSUE(pB, 1);
    SC_UNEXT(0);
    SC_COMMIT(pA, 0);
    __syncthreads();
    for (int n = 0; n < 64; n += 2) {
        SC_ISSUE(pA, n + 2);
        if (n > 0) SC_FLUSH(n - 1, 1);
        SC_GATE(n);
        SC_COMPUTE(n, 0);
        SC_COMMIT(pB, 1);
        __syncthreads();
        SC_ISSUE(pB, n + 3);
        SC_FLUSH(n, 0);
        SC_GATE(n + 1);
        SC_COMPUTE(n + 1, 1);
        SC_COMMIT(pA, 0);
        __syncthreads();
    }
    SC_FLUSH(63, 1);
    __syncthreads();
#undef SC_ISSUE
#undef SC_COMMIT
#undef SC_UNEXT
#undef SC_GATE
#undef SC_FLUSH
#undef SC_COMPUTE
}
constexpr int AT_KS = 13312, AT_STAGE = 22016;
DI float max3f(float a, float b, float c) { float r; asm("v_max3_f32 %0, %1, %2, %3" : "=v"(r) : "v"(a), "v"(b), "v"(c)); return r; }
DI float max2f(float a, float b) { float r; asm("v_max_f32_e32 %0, %1, %2" : "=v"(r) : "v"(a), "v"(b)); return r; }
constexpr float AT_THR = 6.0f;
DI void attn_tile(bool MASK, const LAS unsigned char* Ks, const LAS unsigned char* Vs, const bf16x8 (&qr)[6], f32x16& negm, float& mrun, float& lrun, f32x16& o0, f32x16& o1,
                                       int kv0, int qrow, int r32, int hi) {
    f32x16 p0, p1;
    __builtin_amdgcn_s_setprio(1);
    {
        const bf16x8 a0 = *(const LAS bf16x8*)(Ks + r32 * 208 + hi * 16);
        const bf16x8 a1 = *(const LAS bf16x8*)(Ks + (32 + r32) * 208 + hi * 16);
        p0 = MFMA32(a0, qr[0], negm); p1 = MFMA32(a1, qr[0], negm);
    }
#pragma unroll
    for (int d0 = 1; d0 < 6; ++d0) {
        const bf16x8 a0 = *(const LAS bf16x8*)(Ks + r32 * 208 + (2 * d0 + hi) * 16);
        const bf16x8 a1 = *(const LAS bf16x8*)(Ks + (32 + r32) * 208 + (2 * d0 + hi) * 16);
        p0 = MFMA32(a0, qr[d0], p0); p1 = MFMA32(a1, qr[d0], p1);
    }
    __builtin_amdgcn_s_setprio(0);
    if (MASK) {
        asm volatile("" ::: "memory");
#pragma unroll
        for (int r = 0; r < 16; ++r) { const int kv = kv0 + crow(r, hi); if (kv > qrow) p0[r] = -INFINITY; if (kv + 32 > qrow) p1[r] = -INFINITY; }
    }
    float mxa = max3f(p0[0], p0[1], p1[0]), mxb = max3f(p0[2], p0[3], p1[1]); mxa = max3f(mxa, p1[2], p1[3]);
#pragma unroll
    for (int r = 4; r < 16; r += 4) { mxa = max3f(mxa, p0[r], p0[r + 1]); mxb = max3f(mxb, p0[r + 2], p0[r + 3]); mxa = max3f(mxa, p1[r], p1[r + 1]); mxb = max3f(mxb, p1[r + 2], p1[r + 3]); }
    float mx = max2f(mxa, mxb);
    mx = max2f(mx, __shfl_xor(mx, 32));
    if (__any(mx > AT_THR)) {
        const float dm = max2f(mx, 0.f);
        const float alpha = __builtin_amdgcn_exp2f(-dm);
        mrun += dm; lrun *= alpha;
#pragma unroll
        for (int r = 0; r < 16; ++r) { o0[r] *= alpha; o1[r] *= alpha; p0[r] -= dm; p1[r] -= dm; negm[r] = -mrun; }
    }
    float ls = 0.f;
#pragma unroll
    for (int r = 0; r < 16; ++r) { p0[r] = __builtin_amdgcn_exp2f(p0[r]); p1[r] = __builtin_amdgcn_exp2f(p1[r]); ls += p0[r] + p1[r]; }
    lrun += ls;
#pragma unroll
    for (int ks = 0; ks < 4; ++ks) {
        u32x4 pp;
        if (ks == 0) { pp.x = pk2(p0[0], p0[1]); pp.y = pk2(p0[2], p0[3]); pp.z = pk2(p0[4], p0[5]); pp.w = pk2(p0[6], p0[7]); }
        else if (ks == 1) { pp.x = pk2(p0[8], p0[9]); pp.y = pk2(p0[10], p0[11]); pp.z = pk2(p0[12], p0[13]); pp.w = pk2(p0[14], p0[15]); }
        else if (ks == 2) { pp.x = pk2(p1[0], p1[1]); pp.y = pk2(p1[2], p1[3]); pp.z = pk2(p1[4], p1[5]); pp.w = pk2(p1[6], p1[7]); }
        else { pp.x = pk2(p1[8], p1[9]); pp.y = pk2(p1[10], p1[11]); pp.z = pk2(p1[12], p1[13]); pp.w = pk2(p1[14], p1[15]); }
        const bf16x8 pa = __builtin_bit_cast(bf16x8, pp);
        const LAS unsigned char* vp = Vs + r32 * 136 + (16 * ks + 4 * hi) * 2;
        const u32x2 l0 = *(const LAS u32x2*)vp, h0 = *(const LAS u32x2*)(vp + 16);
        const u32x2 l1 = *(const LAS u32x2*)(vp + 32 * 136), h1 = *(const LAS u32x2*)(vp + 32 * 136 + 16);
        u32x4 v0 = {l0.x, l0.y, h0.x, h0.y}, v1 = {l1.x, l1.y, h1.x, h1.y};
        o0 = MFMA32(__builtin_bit_cast(bf16x8, v0), pa, o0);
        o1 = MFMA32(__builtin_bit_cast(bf16x8, v1), pa, o1);
    }
}
#ifdef ATTN_DUP
DI void attn_dup_qk(const LAS unsigned char* Ks, const bf16x8 (&qr)[6], const f32x16& negm, int r32, int hi) {
    f32x16 p0, p1;
    { const bf16x8 a0 = *(const LAS bf16x8*)(Ks + r32 * 208 + hi * 16); const bf16x8 a1 = *(const LAS bf16x8*)(Ks + (32 + r32) * 208 + hi * 16); p0 = MFMA32(a0, qr[0], negm); p1 = MFMA32(a1, qr[0], negm); }
#pragma unroll
    for (int d0 = 1; d0 < 6; ++d0) { const bf16x8 a0 = *(const LAS bf16x8*)(Ks + r32 * 208 + (2 * d0 + hi) * 16); const bf16x8 a1 = *(const LAS bf16x8*)(Ks + (32 + r32) * 208 + (2 * d0 + hi) * 16); p0 = MFMA32(a0, qr[d0], p0); p1 = MFMA32(a1, qr[d0], p1); }
    float mxa = max3f(p0[0], p0[1], p1[0]), mxb = max3f(p0[2], p0[3], p1[1]); mxa = max3f(mxa, p1[2], p1[3]);
#pragma unroll
    for (int r = 4; r < 16; r += 4) { mxa = max3f(mxa, p0[r], p0[r + 1]); mxb = max3f(mxb, p0[r + 2], p0[r + 3]); mxa = max3f(mxa, p1[r], p1[r + 1]); mxb = max3f(mxb, p1[r + 2], p1[r + 3]); }
    float mx = max2f(mxa, mxb); mx = max2f(mx, __shfl_xor(mx, 32));
    float ls = mx;
#pragma unroll
    for (int r = 0; r < 16; ++r) { ls += __builtin_amdgcn_exp2f(p0[r]) + __builtin_amdgcn_exp2f(p1[r]); }
    asm volatile("" :: "v"(ls));
}
#define AT_DUP(t) attn_dup_qk(Ks_, qr, negm, r32, hi);
#else
#define AT_DUP(t)
#endif
DI void attn_unit(int b, int h, int qb, const bf16* Qb, const bf16* Kb, const bf16* Vt, const int* positions, bf16* O, LAS unsigned char* lds, int tid) {
    const int wave = __builtin_amdgcn_readfirstlane(tid >> 6), lane = tid & 63, r32 = lane & 31, hi = lane >> 5;
    const int rowbase = b * T, q0 = qb * 256, qrow = q0 + 32 * wave + r32;
    const int kkey0 = tid / 12, kc0 = tid % 12, vd = tid >> 3, vc = tid & 7;
    const bf16* kg0 = Kb + (size_t)(rowbase + kkey0) * 768 + h * 96 + kc0 * 8;
    const bf16* vg = Vt + (size_t)(h * 64 + vd) * VT_LD + rowbase + vc * 8;
    const int NT = (q0 + 256) / 64, NTF = q0 / 64;
    const int kp1 = tid < 256 ? 512 + tid : tid;
    const int kkey1 = kp1 / 12, kc1 = kp1 % 12;
    const bf16* kg1 = Kb + (size_t)(rowbase + kkey1) * 768 + h * 96 + kc1 * 8;
    u32x4 kA0, kA1, vA, kB0, kB1, vB, kC0, kC1, vC;
#define AT_COMMIT(S, stage) do { LAS unsigned char* Ks_ = lds + (stage) * AT_STAGE; LAS unsigned char* Vs_ = Ks_ + AT_KS; \
        *(LAS u32x4*)(Ks_ + kkey0 * 208 + kc0 * 16) = k##S##0; *(LAS u32x4*)(Ks_ + kkey1 * 208 + kc1 * 16) = k##S##1; \
        *(LAS u32x2*)(Vs_ + vd * 136 + vc * 16) = (u32x2){v##S.x, v##S.y}; *(LAS u32x2*)(Vs_ + vd * 136 + vc * 16 + 8) = (u32x2){v##S.z, v##S.w}; } while (0)
#define AT_ISSUE(S, t) do { const int tt_ = (t) < NT ? (t) : NT - 1; const size_t ko_ = (size_t)tt_ * 64 * 768; \
        k##S##0 = *(const u32x4*)(kg0 + ko_); k##S##1 = *(const u32x4*)(kg1 + ko_); v##S = *(const u32x4*)(vg + tt_ * 64); } while (0)
#define AT_TILE(t, stage) do { if ((t) < NT && 64 * (t) <= qmax_w) { const LAS unsigned char* Ks_ = lds + (stage) * AT_STAGE; \
        attn_tile((t) >= NTF, Ks_, Ks_ + AT_KS, qr, negm, mrun, lrun, o0, o1, 64 * (t), qrow, r32, hi); AT_DUP(t) } } while (0)
    AT_ISSUE(A, 0); AT_ISSUE(B, 1); AT_ISSUE(C, 2);
    bf16x8 qr[6];
    {
        const bf16* qp = Qb + (size_t)(rowbase + qrow) * 768 + h * 96 + 8 * hi;
        float qv[6][8];
#pragma unroll
        for (int d0 = 0; d0 < 6; ++d0) { const u32x4 a = *(const u32x4*)(qp + 16 * d0);
            qv[d0][0] = bflo(a.x); qv[d0][1] = bfhi(a.x); qv[d0][2] = bflo(a.y); qv[d0][3] = bfhi(a.y); qv[d0][4] = bflo(a.z); qv[d0][5] = bfhi(a.z); qv[d0][6] = bflo(a.w); qv[d0][7] = bfhi(a.w); }
        const int pos = positions[rowbase + qrow];
#pragma unroll
        for (int i = 0; i < 8; ++i) { float c, s; rope_cs(pos, 8 * hi + i, c, s); const float x1 = qv[4][i], x2 = qv[5][i]; qv[4][i] = x1 * c - x2 * s; qv[5][i] = x1 * s + x2 * c; }
        const float C2 = 0.10206207261596575f * 1.4426950408889634f;
#pragma unroll
        for (int d0 = 0; d0 < 6; ++d0) { u32x4 p; p.x = pk2(qv[d0][0] * C2, qv[d0][1] * C2); p.y = pk2(qv[d0][2] * C2, qv[d0][3] * C2); p.z = pk2(qv[d0][4] * C2, qv[d0][5] * C2); p.w = pk2(qv[d0][6] * C2, qv[d0][7] * C2);
            qr[d0] = __builtin_bit_cast(bf16x8, p); }
    }
    AT_COMMIT(A, 0);
    AT_ISSUE(A, 3);
    float mrun = 0.f, lrun = 0.f;
    f32x16 o0 = {}, o1 = {}, negm = {};
    const int qmax_w = q0 + 32 * wave + 31;
    for (int t = 0; t < NT; t += 3) {
        __syncthreads();
        AT_COMMIT(B, 1); AT_ISSUE(B, t + 4);
        AT_TILE(t, 0);
        __syncthreads();
        AT_COMMIT(C, 2); AT_ISSUE(C, t + 5);
        AT_TILE(t + 1, 1);
        __syncthreads();
        AT_COMMIT(A, 0); AT_ISSUE(A, t + 6);
        AT_TILE(t + 2, 2);
    }
    __syncthreads();
#undef AT_COMMIT
#undef AT_ISSUE
#undef AT_TILE
    lrun += __shfl_xor(lrun, 32);
    const float inv = 1.0f / lrun;
    bf16* op = O + (size_t)(rowbase + qrow) * 1024 + h * 64;
#pragma unroll
    for (int g4 = 0; g4 < 4; ++g4) {
        const int d0 = 8 * g4 + 4 * hi;
        u32x2 w; w.x = pk2(o0[4 * g4] * inv, o0[4 * g4 + 1] * inv); w.y = pk2(o0[4 * g4 + 2] * inv, o0[4 * g4 + 3] * inv); *(u32x2*)(op + d0) = w;
        w.x = pk2(o1[4 * g4] * inv, o1[4 * g4 + 1] * inv); w.y = pk2(o1[4 * g4 + 2] * inv, o1[4 * g4 + 3] * inv); *(u32x2*)(op + 32 + d0) = w;
    }
}


#define XB_TMO      128
#define XB_XCNT(j)  (256  + 64 * (j))
#define XB_XSUB(j)  (1280 + 64 * (j))
#define XB_XGEN(j)  (2304 + 64 * (j))
#define XB_TOP      3328
#define XB_TOPGEN   3392
#define XCD_BAR_WORDS 3456
#define XB_QHEAD(j) (3520 + 64 * (j))
#define BAR_ZERO_WORDS 4096
#define XB_SPIN_CAP (1u << 21)
__device__ __forceinline__ unsigned xb_ld(unsigned* p)              { return __hip_atomic_load(p, __ATOMIC_RELAXED, __HIP_MEMORY_SCOPE_AGENT); }
__device__ __forceinline__ unsigned xb_add(unsigned* p, unsigned v) { return __hip_atomic_fetch_add(p, v, __ATOMIC_RELAXED, __HIP_MEMORY_SCOPE_AGENT); }
__device__ __forceinline__ unsigned xb_xcc_id() { return (unsigned)__builtin_amdgcn_s_getreg((3 << 11) | 20) & 0xFu; }
#define XB_SPIN(cond, bar) do { unsigned _sp = 0; while (cond) { __builtin_amdgcn_s_sleep(1); \
    if ((++_sp & 255u) == 0u) { if (xb_ld(&(bar)[XB_TMO])) break; if (_sp > XB_SPIN_CAP) { atomicAdd(&(bar)[XB_TMO], 1u); break; } } } } while (0)
struct XcdBarrier { unsigned* bar; unsigned x; volatile LAS unsigned* st; };
__device__ __forceinline__ XcdBarrier xcd_barrier_post(unsigned* bar, volatile LAS unsigned* st) {
    XcdBarrier b; b.bar = bar; b.x = xb_xcc_id(); b.st = st;
    if (threadIdx.x == 0) (void)xb_add(&bar[XB_XCNT(b.x)], 1u);
    return b;
}
__device__ __forceinline__ void xcd_barrier_complete(unsigned* bar, unsigned x, unsigned& nloc, unsigned& nx) {
    const unsigned G = gridDim.x * gridDim.y * gridDim.z;
    unsigned sum, cnt, mine, sp = 0u;
    for (;;) {
        sum = 0u; cnt = 0u; mine = 0u;
#pragma unroll
        for (unsigned j = 0; j < 16; ++j) { const unsigned c = xb_ld(&bar[XB_XCNT(j)]); sum += c; cnt += (c > 0u) ? 1u : 0u; mine = (j == x) ? c : mine; }
        if (sum == G) break;
        __builtin_amdgcn_s_sleep(1);
        if ((++sp & 255u) == 0u) { if (xb_ld(&bar[XB_TMO])) break; if (sp > XB_SPIN_CAP) { atomicAdd(&bar[XB_TMO], 1u); break; } }
    }
    nloc = mine > 0u ? mine : 1u; nx = cnt > 0u ? cnt : 1u;
}
__device__ __forceinline__ void xcd_barrier(const XcdBarrier& b) {
    asm volatile("s_waitcnt vmcnt(0)" ::: "memory");
    __syncthreads();
    if (threadIdx.x == 0) {
        unsigned* bar = b.bar;
        __builtin_amdgcn_s_waitcnt(0);
        unsigned nloc = b.st[0], nx = b.st[1];
        if (nloc == 0u) { xcd_barrier_complete(bar, b.x, nloc, nx); b.st[0] = nloc; b.st[1] = nx; }
        const unsigned old = xb_add(&bar[XB_XSUB(b.x)], 1u);
        const unsigned gen = old / nloc;
        if (old + 1u == (gen + 1u) * nloc) {
            __builtin_amdgcn_fence(__ATOMIC_RELEASE, "agent");
            asm volatile("s_waitcnt vmcnt(0)" ::: "memory");
            const unsigned og = xb_add(&bar[XB_TOP], 1u);
            const unsigned tg = og / nx;
            if (og + 1u == (tg + 1u) * nx) xb_add(&bar[XB_TOPGEN], 1u);
            else XB_SPIN(xb_ld(&bar[XB_TOPGEN]) == tg, bar);
            __builtin_amdgcn_fence(__ATOMIC_ACQUIRE, "agent");
            xb_add(&bar[XB_XGEN(b.x)], 1u);
            asm volatile("s_waitcnt vmcnt(0)" ::: "memory");
        } else {
            XB_SPIN(xb_ld(&bar[XB_XGEN(b.x)]) == gen, bar);
            __builtin_amdgcn_fence(__ATOMIC_ACQUIRE, "agent");
            asm volatile("s_waitcnt vmcnt(0)" ::: "memory");
        }
    }
    __syncthreads();
}
#ifndef MK_PER_PHASE
#define MK_PER_PHASE 0
#endif
__global__ void __launch_bounds__(512, 2) mk_fwd(Args a) {
    extern __shared__ __attribute__((aligned(16))) unsigned char lds_raw[];
    LAS unsigned char* lds = (LAS unsigned char*)lds_raw;
    cg::grid_group grid = cg::this_grid();
    const int tid = threadIdx.x, lane = tid & 63, wave = __builtin_amdgcn_readfirstlane(tid >> 6);
    const int G = gridDim.x, bid = blockIdx.x, gw = bid * 8 + wave, NGW = G * 8;
    const int lo = a.ph_lo, hi = a.ph_hi;
#ifndef PHMASK
#define PHMASK 0xffff
#endif
#define IN(k) (((PHMASK >> (k)) & 1) && lo <= (k) && (k) < hi)
#define SEAM(k) do { if (IN(k) && IN((k) + 1)) xcd_barrier(xbar); } while (0)
#ifndef PHREP
#define PHREP 0
#endif
#ifndef XSYNC
#define XSYNC 0
#endif
#define PH(k) if (IN(k)) for (int rep_ = 0; rep_ < (((PHREP >> (k)) & 1) ? 2 : 1); ++rep_)
    unsigned char* ws = a.ws;
    unsigned* barw = (unsigned*)(ws + WS_BAR);
    volatile LAS unsigned* st = (volatile LAS unsigned*)(lds + LDS_BYTES - 16);
    LAS int* qslot = (LAS int*)(lds + LDS_BYTES - 32);
    if (tid < 4) st[tid] = 0u;
    __syncthreads();
    XcdBarrier xbar; xbar.bar = barw; xbar.x = 0; xbar.st = st;
    if (hi - lo > 1) xbar = xcd_barrier_post(barw, st);
    if (lo < 0) grid.sync();
    const float* x = (const float*)a.in[0]; const int* positions = (const int*)a.in[1];
    bf16* W1GU = (bf16*)(ws + WS_W1GU); bf16* W1D = (bf16*)(ws + WS_W1D); bf16* WIN = (bf16*)(ws + WS_WIN); bf16* WUQ = (bf16*)(ws + WS_WUQ); bf16* WKV = (bf16*)(ws + WS_WKV);
    bf16* WOUT = (bf16*)(ws + WS_WOUT); bf16* W2GU = (bf16*)(ws + WS_W2GU); bf16* W2D = (bf16*)(ws + WS_W2D);
    float* ROWSQ = (float*)(ws + WS_ROWSQ); float* GLAST = (float*)(ws + WS_GLAST); float* RS2 = (float*)(ws + WS_RS); float* RS3 = RS2 + M;
    bf16* P = (bf16*)(ws + WS_P); bf16* Q = (bf16*)(ws + WS_Q); bf16* H = (bf16*)(ws + WS_H); unsigned char* GB = ws + WS_G;
    bf16* CQN = (bf16*)(ws + WS_P + P_CQN); bf16* CKVN = (bf16*)(ws + WS_P + P_CKVN); bf16* MLAO = (bf16*)(ws + WS_P + P_MLAO);
    bf16* PS = (bf16*)(ws + WS_H + H_PS); bf16* QKV = (bf16*)(ws + WS_H + H_QKV); bf16* KB = (bf16*)(ws + WS_H + H_KB); bf16* VT = (bf16*)(ws + WS_H + H_VT); bf16* OG = (bf16*)(ws + WS_H + H_OG);
    LAS unsigned char* wl = lds + wave * WAVE_LDS;

    PH(0) {
        LAS float* scr = (LAS float*)wl;
        constexpr int I_GU = 16 * 88, I_D = 44 * 32, I_IN = 16 * 78, I_UQ = 4 * 24, I_KV = 2 * 32, I_OUT = 16 * 32;
        constexpr int NITEMS = 2 * (2 * I_GU + I_D) + I_IN + I_UQ + I_KV + I_OUT;
        for (int it = gw; it < NITEMS; it += NGW) {
            int r = it;
            if (r < I_GU) { transpose_item((const float*)a.in[3], 1024, 2816, W1GU, 1, scr, r, lane); continue; } r -= I_GU;
            if (r < I_GU) { transpose_item((const float*)a.in[4], 1024, 2816, W1GU, 2, scr, r, lane); continue; } r -= I_GU;
            if (r < I_D) { transpose_item((const float*)a.in[5], 2816, 1024, W1D, 0, scr, r, lane); continue; } r -= I_D;
            if (r < I_GU) { transpose_item((const float*)a.in[21], 1024, 2816, W2GU, 1, scr, r, lane, (const float*)a.in[20]); continue; } r -= I_GU;
            if (r < I_GU) { transpose_item((const float*)a.in[22], 1024, 2816, W2GU, 2, scr, r, lane, (const float*)a.in[20]); continue; } r -= I_GU;
            if (r < I_D) { transpose_item((const float*)a.in[23], 2816, 1024, W2D, 0, scr, r, lane); continue; } r -= I_D;
            if (r < I_IN) { transpose_item((const float*)a.in[8], 1024, 2480, WIN, 3, scr, r, lane, (const float*)a.in[7]); continue; } r -= I_IN;
            if (r < I_UQ) { transpose_item((const float*)a.in[10], 256, 768, WUQ, 0, scr, r, lane); continue; } r -= I_UQ;
            if (r < I_KV) { transpose_item((const float*)a.in[12], 128, 1024, WKV, 4, scr, r, lane); continue; } r -= I_KV;
            transpose_item((const float*)a.in[18], 1024, 1024, WOUT, 0, scr, r, lane);
        }
        for (int i = bid * 512 + tid; i < 80 * 1024 / 8; i += G * 512) *(u32x4*)(WIN + 944 * 1024 + (size_t)i * 8) = (u32x4){0u, 0u, 0u, 0u};
        for (int m = gw; m < M; m += 4 * NGW) rms_rows_to_bf16<4>(x, (const float*)a.in[2], P, m, NGW, lane);
    }
    SEAM(0);
    for (int xs_ = 0; xs_ < XSYNC; ++xs_) grid.sync();
    PH(1) {
        pg8::Gemm g{P, W1GU, M, 5632, 1024}; pg8::StaticOrder S; S.init(M, 5632, G, bid);
        pg8::EpiSwiGLU E{H, FF, nullptr};
        pg8::gemm_phase<pg8::EpiSwiGLU, pg8::StaticOrder, true, true>(lds, g, S, E);
    }
    SEAM(1);
    PH(2) {
        pg8::Gemm g{H, W1D, M, 1024, 2816}; pg8::StaticOrder S; S.init(M, 1024, G, bid);
        pg8::EpiBf16Sq E{Q, ROWSQ};
        pg8::gemm_phase<pg8::EpiBf16Sq, pg8::StaticOrder, true, true>(lds, g, S, E);
    }
    SEAM(2);
    PH(3) {
        for (int m = gw; m < M; m += 4 * NGW) resid_rows<4, false, true>(x, a.out, Q, ROWSQ, 0.5f, (const float*)a.in[6], nullptr, nullptr, m, NGW, lane, RS2);
    }
    SEAM(3);
    PH(4) {
        pg8::Gemm g{(const bf16*)a.out, WIN, M, 2560, 1024}; pg8::StaticOrder S; S.init(M, 2560, G, bid);
        pg8::EpiStore<1> E{PS, 1024, QKV, RS2};
        pg8::gemm_phase<pg8::EpiStore<1>, pg8::StaticOrder, true, true>(lds, g, S, E);
    }
    SEAM(4);
    PH(5) {
        for (int m = gw; m < M; m += 4 * NGW) e2_rows<4>(PS, (const float*)a.in[9], (const float*)a.in[11], CQN, CKVN, m, NGW, lane);
        for (int uid = gw; uid < 4096; uid += NGW)
            gdn_prep_unit(uid, QKV, PS, (const float*)a.in[14], (const float*)a.in[15], (const float*)a.in[16], GB, GLAST, wl, lane);
    }
    SEAM(5);
    PH(6) {
#ifndef P6SEL
#define P6SEL 15
#endif
        if (P6SEL & 1) for (int m = gw; m < M; m += 4 * NGW) kpe_rows<4>(PS, positions, KB, m, NGW, lane);
        if (P6SEL & 2) { int kq = 256; asm volatile("" : "+s"(kq)); pg8::Gemm g{CQN, WUQ, M, 768, kq}; pg8::StaticOrder S; S.init(M, 768, G, bid); pg8::EpiStore<0> E{Q, 768, nullptr, nullptr};
          pg8::gemm_phase<pg8::EpiStore<0>, pg8::StaticOrder, true, false>(lds, g, S, E); }
        if (P6SEL & 4) { int kq = 128; asm volatile("" : "+s"(kq)); pg8::Gemm g{CKVN, WKV, M, 512, kq}; pg8::StaticOrder S; S.init(M, 512, G, bid); pg8::EpiStore<2> E{KB, 768, nullptr, nullptr};
          pg8::gemm_phase<pg8::EpiStore<2>, pg8::StaticOrder, true, false>(lds, g, S, E); }
        if ((P6SEL & 8) && (G != 256 || bid >= 128)) { int kq = 128; asm volatile("" : "+s"(kq)); pg8::Gemm g{WKV + 512 * 128, CKVN, 512, M, kq}; pg8::StaticOrder S;
          if (G == 256) S.init(512, M, 128, bid - 128); else S.init(512, M, G, bid);     pg8::EpiStore<0> E{VT, VT_LD, nullptr, nullptr};
          pg8::gemm_phase<pg8::EpiStore<0>, pg8::StaticOrder, true, false>(lds, g, S, E); }
    }
    SEAM(6);
    PH(7) {
#ifndef SCANREP
#define SCANREP 1
#endif
        for (int sr_ = 0; sr_ < SCANREP; ++sr_) for (int s = bid; s < 64; s += G) gdn_scan(s >> 3, s & 7, GB, GLAST, PS, (const float*)a.in[17], P, lds, tid);
        const int NQ = G >= 8 ? 8 : 1, xq = bid % NQ, per_q = 1024 / NQ;
#ifndef ATTNREP
#define ATTNREP 1
#endif
        int ticket = 0;
        if (tid == 0) ticket = (int)xb_add(&barw[XB_QHEAD(xq)], 1u);
        if (tid == 0) *qslot = ticket;
        __syncthreads();
        int q = *qslot;
        __syncthreads();
        while (q < per_q) {
            if (tid == 0) ticket = (int)xb_add(&barw[XB_QHEAD(xq)], 1u);
            const int bh = NQ == 8 ? xq * 8 + (q & 7) : (q & 63), qb = NQ == 8 ? 15 - (q >> 3) : 15 - (q >> 6);
            for (int ar_ = 0; ar_ < ATTNREP; ++ar_) attn_unit(bh >> 3, bh & 7, qb, Q, KB, VT, positions, P, lds, tid);
            if (tid == 0) *qslot = ticket;
            __syncthreads();
            q = *qslot;
            __syncthreads();
        }
    }
    SEAM(7);
    PH(8) {
        for (int m = gw; m < M; m += 4 * NGW) mla_norm_rows<4>(P, (const float*)a.in[13], m, NGW, lane);
    }
    SEAM(8);
    PH(9) {
        pg8::Gemm g{P, WOUT, M, 1024, 1024}; pg8::StaticOrder S; S.init(M, 1024, G, bid);
        pg8::EpiBf16Sq E{Q, ROWSQ};
        pg8::gemm_phase<pg8::EpiBf16Sq, pg8::StaticOrder, true, true>(lds, g, S, E);
    }
    SEAM(9);
    PH(10) {
        for (int m = gw; m < M; m += 4 * NGW) resid_rows<4, true, true>(a.out, GB, Q, ROWSQ, 1.0f, (const float*)a.in[19], nullptr, nullptr, m, NGW, lane, RS3);
    }
    SEAM(10);
    PH(11) {
        pg8::Gemm g{(const bf16*)GB, W2GU, M, 5632, 1024}; pg8::StaticOrder S; S.init(M, 5632, G, bid);
        pg8::EpiSwiGLU E{H, FF, RS3};
        pg8::gemm_phase<pg8::EpiSwiGLU, pg8::StaticOrder, true, true>(lds, g, S, E);
    }
    SEAM(11);
    PH(12) {
        pg8::Gemm g{H, W2D, M, 1024, 2816}; pg8::StaticOrder S; S.init(M, 1024, G, bid);
        pg8::EpiBf16Sq E{Q, ROWSQ};
        pg8::gemm_phase<pg8::EpiBf16Sq, pg8::StaticOrder, true, true>(lds, g, S, E);
    }
    SEAM(12);
    PH(13) {
        for (int m = gw; m < M; m += 4 * NGW) resid_rows<4, true, false>(GB, a.out, Q, ROWSQ, 0.5f, (const float*)a.in[24], nullptr, nullptr, m, NGW, lane);
    }
#undef IN
#undef SEAM
}

extern "C" void kernel_launch(void* const* d_in, const int* in_sizes, int n_in, void* d_out, int out_size, void* d_ws, size_t ws_size, hipStream_t stream) {
    static int grid = 0;
    if (grid == 0) {
        if (n_in != 25 || out_size != M * DM || ws_size < WS_END) { fprintf(stderr, "kernel_launch: unexpected problem shape / workspace (n_in %d out %d ws %zu need %zu)\n", n_in, out_size, ws_size, (size_t)WS_END); grid = -1; return; }
        int dev = 0, cus = 0, per_cu = 0;
        if (hipGetDevice(&dev) != hipSuccess || hipDeviceGetAttribute(&cus, hipDeviceAttributeMultiprocessorCount, dev) != hipSuccess) { grid = -1; return; }
        if (hipFuncSetAttribute((const void*)mk_fwd, hipFuncAttributeMaxDynamicSharedMemorySize, LDS_BYTES) != hipSuccess) { fprintf(stderr, "kernel_launch: hipFuncSetAttribute failed\n"); grid = -1; return; }
        if (hipOccupancyMaxActiveBlocksPerMultiprocessor(&per_cu, (const void*)mk_fwd, 512, LDS_BYTES) != hipSuccess || per_cu < 1) { fprintf(stderr, "kernel_launch: occupancy query says %d blocks per CU\n", per_cu); (void)hipGetLastError(); per_cu = 1; }
        grid = cus * 1;
    }
    if (grid < 0) return;
    Args a{};
    for (int i = 0; i < 25; ++i) a.in[i] = d_in[i];
    a.out = (float*)d_out; a.ws = (unsigned char*)d_ws;
#if MK_PER_PHASE
    for (int p = 0; p < NPH; ++p) { a.ph_lo = p; a.ph_hi = p + 1; hipLaunchKernelGGL(mk_fwd, dim3(grid), dim3(512), LDS_BYTES, stream, a); }
#else
    a.ph_lo = 0; a.ph_hi = NPH;
    if (hipMemsetAsync((unsigned char*)d_ws + WS_BAR, 0, BAR_ZERO_WORDS * 4, stream) != hipSuccess) { fprintf(stderr, "kernel_launch: memset of the barrier words failed\n"); return; }
    void* args[] = {&a};
    hipError_t e = hipLaunchCooperativeKernel((const void*)mk_fwd, dim3(grid), dim3(512), args, LDS_BYTES, stream);
    if (e != hipSuccess) fprintf(stderr, "kernel_launch: cooperative launch failed: %s (grid %d)\n", hipGetErrorString(e), grid);
#endif
}
```
